# Optimizing an MI355X kernel written in HIP

```python
import math
import jax, jax.numpy as jnp
from jax import lax
import numpy as np


D_MODEL = 2048
BATCH = 4
SEQ = 2048
DEPTH = 4

D_MIX = D_MODEL
N_EVEN = (DEPTH + 1) // 2
N_ODD = DEPTH // 2
A_WIDTH = D_MIX // 2
A_HEAD_DIM = 128
A_HEADS = A_WIDTH // A_HEAD_DIM
A_CONV = 4
CHUNK = 64
B_WIDTH = D_MIX - A_WIDTH
S5_GROUP = 16
S5_GROUPS = B_WIDTH // S5_GROUP
S5_STATE = 64
C_WIDTH = D_MIX // 2
C_CONV = 3
D_WIDTH = D_MIX - C_WIDTH
DA_HEAD_DIM = 128
DA_HEADS = D_WIDTH // (2 * DA_HEAD_DIM)
Q_BLOCK = 128
D_FF = ((8 * D_MODEL // 3 + 255) // 256) * 256
AB_IN = 4 * A_WIDTH + 2 * A_HEADS + B_WIDTH
CD_IN = 3 * C_WIDTH + 3 * D_WIDTH
ALPHA = (2.0 * DEPTH) ** 0.25
BETA = (8.0 * DEPTH) ** -0.25
EPS = 1e-5

kernel_name = "hybrid_deltanet_s5_shortconv_diffattn_deepnorm_adaln"


def layer_norm(x, g, b):
    xf = x.astype(jnp.float32)
    mu = jnp.mean(xf, axis=-1, keepdims=True)
    var = jnp.mean(jnp.square(xf - mu), axis=-1, keepdims=True)
    return ((xf - mu) * lax.rsqrt(var + EPS) * g + b).astype(x.dtype)


def rms_norm(x, g):
    xf = x.astype(jnp.float32)
    return xf * lax.rsqrt(jnp.mean(jnp.square(xf), axis=-1, keepdims=True) + EPS) * g


def l2_normalize(t):
    return t * lax.rsqrt(jnp.sum(jnp.square(t), axis=-1, keepdims=True) + 1e-6)


def causal_dwconv(x, w):
    K = w.shape[0]
    L = x.shape[1]
    xp = jnp.pad(x, ((0, 0), (K - 1, 0), (0, 0)))
    return sum(w[k] * xp[:, k:k + L] for k in range(K))


def chunk_gated_delta(q, k, v, g, beta):
    Bsz, H, L, dk = q.shape
    dv = v.shape[-1]
    n = L // CHUNK
    q = q.reshape(Bsz, H, n, CHUNK, dk)
    k = k.reshape(Bsz, H, n, CHUNK, dk)
    v = v.reshape(Bsz, H, n, CHUNK, dv)
    g = jnp.cumsum(g.reshape(Bsz, H, n, CHUNK), axis=-1)
    beta = beta.reshape(Bsz, H, n, CHUNK)
    tril = jnp.tril(jnp.ones((CHUNK, CHUNK), dtype=bool))
    strict = jnp.tril(jnp.ones((CHUNK, CHUNK), dtype=bool), k=-1)
    gdiff = g[..., :, None] - g[..., None, :]
    decay = jnp.where(tril, jnp.exp(jnp.where(tril, gdiff, 0.0)), 0.0)
    k_beta = k * beta[..., None]
    v_beta = v * beta[..., None]
    lower = jnp.where(strict, jnp.einsum('bhnid,bhnjd->bhnij', k_beta, k) * decay, 0.0)
    eye = jnp.eye(CHUNK, dtype=jnp.float32)
    T = lax.linalg.triangular_solve(eye + lower, jnp.broadcast_to(eye, lower.shape),
                                    left_side=True, lower=True, unit_diagonal=True)
    u = jnp.einsum('bhnij,bhnjd->bhnid', T, v_beta)
    w = jnp.einsum('bhnij,bhnjd->bhnid', T, k_beta * jnp.exp(g)[..., None])
    intra = jnp.where(tril, jnp.einsum('bhnid,bhnjd->bhnij', q, k) * decay, 0.0)
    q_decay = q * jnp.exp(g)[..., None]
    k_tail = k * jnp.exp(g[..., -1:] - g)[..., None]
    g_last = jnp.exp(g[..., -1])

    def step(S, inp):
        u_n, w_n, qd_n, a_n, kt_n, gl_n = inp
        v_new = u_n - jnp.einsum('bhik,bhkv->bhiv', w_n, S)
        o_n = jnp.einsum('bhik,bhkv->bhiv', qd_n, S) + jnp.einsum('bhij,bhjv->bhiv', a_n, v_new)
        S = S * gl_n[..., None, None] + jnp.einsum('bhik,bhiv->bhkv', kt_n, v_new)
        return S, o_n

    xs = (jnp.moveaxis(u, 2, 0), jnp.moveaxis(w, 2, 0), jnp.moveaxis(q_decay, 2, 0),
          jnp.moveaxis(intra, 2, 0), jnp.moveaxis(k_tail, 2, 0), jnp.moveaxis(g_last, 2, 0))
    S0 = jnp.zeros((Bsz, H, dk, dv), jnp.float32)
    _, o = lax.scan(step, S0, xs)
    return jnp.moveaxis(o, 0, 2).reshape(Bsz, H, L, dv)


def gated_deltanet(q, k, v, z, b, a, conv_w, a_log, dt_bias, norm_g):
    Bsz, L, _ = q.shape
    out_dtype = z.dtype
    qkv = jax.nn.silu(causal_dwconv(jnp.concatenate([q, k, v], axis=-1), conv_w)).astype(jnp.float32)
    q, k, v = jnp.split(qkv, 3, axis=-1)

    def heads(t):
        return t.reshape(Bsz, L, A_HEADS, A_HEAD_DIM).transpose(0, 2, 1, 3)

    q = l2_normalize(heads(q)) * (A_HEAD_DIM ** -0.5)
    k = l2_normalize(heads(k))
    v = heads(v)
    beta = jax.nn.sigmoid(b.astype(jnp.float32)).transpose(0, 2, 1)
    g = (-jnp.exp(a_log.astype(jnp.float32))
         * jax.nn.softplus(a.astype(jnp.float32) + dt_bias.astype(jnp.float32))).transpose(0, 2, 1)
    o = chunk_gated_delta(q, k, v, g, beta).transpose(0, 2, 1, 3)
    zh = z.astype(jnp.float32).reshape(Bsz, L, A_HEADS, A_HEAD_DIM)
    o = rms_norm(o, norm_g) * jax.nn.silu(zh)
    return o.reshape(Bsz, L, A_WIDTH).astype(out_dtype)


def _ssm_combine(left, right):
    a_l, b_l = left
    a_r, b_r = right
    return a_r * a_l, a_r * b_l + b_r


def s5_ssm(u, a_re, a_im, b_re, b_im, c_re, c_im, d, log_dt, w_glu):
    Bsz, L, _ = u.shape
    uf = u.astype(jnp.float32).reshape(Bsz, L, S5_GROUPS, S5_GROUP)
    lam = lax.complex(a_re.astype(jnp.float32), a_im.astype(jnp.float32))
    delta = jnp.exp(log_dt.astype(jnp.float32))[:, None]
    a_bar = jnp.exp(lam * delta)
    b_mat = lax.complex(b_re.astype(jnp.float32), b_im.astype(jnp.float32))
    b_bar = ((a_bar - 1.0) / lam)[:, :, None] * b_mat
    c_mat = lax.complex(c_re.astype(jnp.float32), c_im.astype(jnp.float32))
    bu = jnp.einsum('gpc,blgc->blgp', b_bar, uf.astype(jnp.complex64))
    a_seq = jnp.broadcast_to(a_bar, bu.shape)
    _, states = lax.associative_scan(_ssm_combine, (a_seq, bu), axis=1)
    y = jnp.einsum('gcp,blgp->blgc', c_mat, states).real + d.astype(jnp.float32) * uf
    y = jax.nn.gelu(y).reshape(Bsz, L, B_WIDTH)
    y = y * jax.nn.sigmoid(y @ w_glu.astype(jnp.float32))
    return y.astype(u.dtype)


def diff_attention(q, k, v, lq1, lk1, lq2, lk2, norm_g, lambda_init):
    Bsz, L, _ = q.shape
    out_dtype = v.dtype
    q = q.astype(jnp.float32).reshape(Bsz, L, DA_HEADS, 2, DA_HEAD_DIM).transpose(0, 2, 3, 1, 4)
    k = k.astype(jnp.float32).reshape(Bsz, L, DA_HEADS, 2, DA_HEAD_DIM).transpose(0, 2, 3, 1, 4)
    v = v.astype(jnp.float32).reshape(Bsz, L, DA_HEADS, 2 * DA_HEAD_DIM).transpose(0, 2, 1, 3)
    lam = (jnp.exp(jnp.sum(lq1.astype(jnp.float32) * lk1.astype(jnp.float32)))
           - jnp.exp(jnp.sum(lq2.astype(jnp.float32) * lk2.astype(jnp.float32))) + lambda_init)
    scale = DA_HEAD_DIM ** -0.5
    slopes = 2.0 ** (-8.0 * jnp.arange(1, DA_HEADS + 1, dtype=jnp.float32) / DA_HEADS)
    nb = L // Q_BLOCK
    q_blocks = jnp.moveaxis(q.reshape(Bsz, DA_HEADS, 2, nb, Q_BLOCK, DA_HEAD_DIM), 3, 0)
    kpos = jnp.arange(L)

    def one_block(args):
        qb, bi = args
        qpos = bi * Q_BLOCK + jnp.arange(Q_BLOCK)
        dist = qpos[:, None] - kpos[None, :]
        bias = -slopes[:, None, None] * dist.astype(jnp.float32)
        s = jnp.einsum('bhiqd,bhikd->bhiqk', qb, k) * scale + bias[None, :, None]
        s = jnp.where(dist >= 0, s, -jnp.inf)
        p = jax.nn.softmax(s, axis=-1)
        attn = p[:, :, 0] - lam * p[:, :, 1]
        return jnp.einsum('bhqk,bhkv->bhqv', attn, v)

    o = lax.map(one_block, (q_blocks, jnp.arange(nb)))
    o = jnp.moveaxis(o, 0, 2).reshape(Bsz, DA_HEADS, L, 2 * DA_HEAD_DIM)
    o = rms_norm(o, norm_g) * (1.0 - lambda_init)
    return o.transpose(0, 2, 1, 3).reshape(Bsz, L, D_WIDTH).astype(out_dtype)


def mixer_ab(h, w_in, w_out, conv_w, a_log, dt_bias, norm_g,
             a_re, a_im, b_re, b_im, c_re, c_im, d, log_dt, w_glu):
    proj = h @ w_in
    offs = [A_WIDTH, 2 * A_WIDTH, 3 * A_WIDTH, 4 * A_WIDTH,
            4 * A_WIDTH + A_HEADS, 4 * A_WIDTH + 2 * A_HEADS]
    q, k, v, z, b, a, u = jnp.split(proj, offs, axis=-1)
    ya = gated_deltanet(q, k, v, z, b, a, conv_w, a_log, dt_bias, norm_g)
    yb = s5_ssm(u, a_re, a_im, b_re, b_im, c_re, c_im, d, log_dt, w_glu)
    return jnp.concatenate([ya, yb], axis=-1) @ w_out


def mixer_cd(h, w_in, w_out, conv_w, lq1, lk1, lq2, lk2, norm_g, lambda_init):
    proj = h @ w_in
    offs = [C_WIDTH, 2 * C_WIDTH, 3 * C_WIDTH, 3 * C_WIDTH + D_WIDTH, 3 * C_WIDTH + 2 * D_WIDTH]
    gb, gc, xc, q, k, v = jnp.split(proj, offs, axis=-1)
    yc = gb * causal_dwconv(gc * xc, conv_w)
    yd = diff_attention(q, k, v, lq1, lk1, lq2, lk2, norm_g, lambda_init)
    return jnp.concatenate([yc, yd], axis=-1) @ w_out


def swiglu(h, w_gate, w_up, w_down):
    return (jax.nn.silu(h @ w_gate) * (h @ w_up)) @ w_down


def setup_inputs(seed: int = 0) -> dict:
    key = jax.random.key(seed)
    ks = iter(jax.random.split(key, 48))
    nrm = lambda shape, s: jax.random.normal(next(ks), shape, jnp.float32) * s
    inp = {}
    inp["x"] = nrm((BATCH, SEQ, D_MODEL), 1.0)
    inp["c"] = nrm((BATCH, D_MODEL), 1.0)
    inp["ada_w"] = nrm((DEPTH, D_MODEL, 6 * D_MODEL), 0.1 * D_MODEL ** -0.5)
    inp["ada_b"] = nrm((DEPTH, 6 * D_MODEL), 0.01)
    inp["ln1_g"] = 1.0 + nrm((DEPTH, D_MODEL), 0.02)
    inp["ln1_b"] = nrm((DEPTH, D_MODEL), 0.02)
    inp["ln2_g"] = 1.0 + nrm((DEPTH, D_MODEL), 0.02)
    inp["ln2_b"] = nrm((DEPTH, D_MODEL), 0.02)
    inp["ffn_w_gate"] = nrm((DEPTH, D_MODEL, D_FF), D_MODEL ** -0.5)
    inp["ffn_w_up"] = nrm((DEPTH, D_MODEL, D_FF), D_MODEL ** -0.5)
    inp["ffn_w_down"] = nrm((DEPTH, D_FF, D_MODEL), BETA * D_FF ** -0.5)
    inp["ab_w_in"] = nrm((N_EVEN, D_MODEL, AB_IN), D_MODEL ** -0.5)
    inp["ab_w_out"] = nrm((N_EVEN, D_MIX, D_MODEL), BETA * D_MIX ** -0.5)
    inp["dn_conv_w"] = nrm((N_EVEN, A_CONV, 3 * A_WIDTH), A_CONV ** -0.5)
    inp["dn_a_log"] = jnp.log(jax.random.uniform(next(ks), (N_EVEN, A_HEADS), jnp.float32, 1.0, 16.0))
    dt = jnp.exp(jax.random.uniform(next(ks), (N_EVEN, A_HEADS), jnp.float32,
                                    math.log(1e-3), math.log(1e-1)))
    inp["dn_dt_bias"] = dt + jnp.log(-jnp.expm1(-dt))
    inp["dn_norm_g"] = 1.0 + nrm((N_EVEN, A_HEAD_DIM), 0.02)
    inp["s5_a_re"] = -0.5 + nrm((N_EVEN, S5_GROUPS, S5_STATE), 0.01)
    inp["s5_a_im"] = math.pi * jnp.arange(S5_STATE, dtype=jnp.float32) + nrm((N_EVEN, S5_GROUPS, S5_STATE), 0.01)
    inp["s5_b_re"] = nrm((N_EVEN, S5_GROUPS, S5_STATE, S5_GROUP), (2 * S5_GROUP) ** -0.5)
    inp["s5_b_im"] = nrm((N_EVEN, S5_GROUPS, S5_STATE, S5_GROUP), (2 * S5_GROUP) ** -0.5)
    inp["s5_c_re"] = nrm((N_EVEN, S5_GROUPS, S5_GROUP, S5_STATE), 0.5)
    inp["s5_c_im"] = nrm((N_EVEN, S5_GROUPS, S5_GROUP, S5_STATE), 0.5)
    inp["s5_d"] = nrm((N_EVEN, S5_GROUPS, S5_GROUP), 1.0)
    inp["s5_log_dt"] = jax.random.uniform(next(ks), (N_EVEN, S5_GROUPS), jnp.float32,
                                          math.log(1e-3), math.log(1e-1))
    inp["s5_w_glu"] = nrm((N_EVEN, B_WIDTH, B_WIDTH), B_WIDTH ** -0.5)
    inp["cd_w_in"] = nrm((N_ODD, D_MODEL, CD_IN), D_MODEL ** -0.5)
    inp["cd_w_out"] = nrm((N_ODD, D_MIX, D_MODEL), BETA * D_MIX ** -0.5)
    inp["sc_conv_w"] = nrm((N_ODD, C_CONV, C_WIDTH), C_CONV ** -0.5)
    inp["da_lq1"] = nrm((N_ODD, DA_HEAD_DIM), 0.1)
    inp["da_lk1"] = nrm((N_ODD, DA_HEAD_DIM), 0.1)
    inp["da_lq2"] = nrm((N_ODD, DA_HEAD_DIM), 0.1)
    inp["da_lk2"] = nrm((N_ODD, DA_HEAD_DIM), 0.1)
    inp["da_norm_g"] = 1.0 + nrm((N_ODD, 2 * DA_HEAD_DIM), 0.02)
    return inp


def reference(x, c, ada_w, ada_b, ln1_g, ln1_b, ln2_g, ln2_b, ffn_w_gate, ffn_w_up, ffn_w_down,
              ab_w_in, ab_w_out, dn_conv_w, dn_a_log, dn_dt_bias, dn_norm_g,
              s5_a_re, s5_a_im, s5_b_re, s5_b_im, s5_c_re, s5_c_im, s5_d, s5_log_dt, s5_w_glu,
              cd_w_in, cd_w_out, sc_conv_w, da_lq1, da_lk1, da_lq2, da_lk2, da_norm_g):
    c_act = jax.nn.silu(c)
    for i in range(DEPTH):
        mod = c_act @ ada_w[i] + ada_b[i]
        sh1, sc1, g1, sh2, sc2, g2 = [m[:, None, :] for m in jnp.split(mod, 6, axis=-1)]
        h = x * (1.0 + sc1) + sh1
        j = i // 2
        if i % 2 == 0:
            y = mixer_ab(h, ab_w_in[j], ab_w_out[j], dn_conv_w[j], dn_a_log[j], dn_dt_bias[j],
                         dn_norm_g[j], s5_a_re[j], s5_a_im[j], s5_b_re[j], s5_b_im[j],
                         s5_c_re[j], s5_c_im[j], s5_d[j], s5_log_dt[j], s5_w_glu[j])
        else:
            lambda_init = 0.8 - 0.6 * math.exp(-0.3 * i)
            y = mixer_cd(h, cd_w_in[j], cd_w_out[j], sc_conv_w[j], da_lq1[j], da_lk1[j],
                         da_lq2[j], da_lk2[j], da_norm_g[j], lambda_init)
        x = layer_norm(ALPHA * x + (1.0 + g1) * y, ln1_g[i], ln1_b[i])
        h = x * (1.0 + sc2) + sh2
        y = swiglu(h, ffn_w_gate[i], ffn_w_up[i], ffn_w_down[i])
        x = layer_norm(ALPHA * x + (1.0 + g2) * y, ln2_g[i], ln2_b[i])
    return x
```

```cpp
#include <hip/hip_runtime.h>
#include <cstdio>
#include <cstdint>
#ifndef MK_MULTI
#define MK_MULTI 1
#endif
namespace pg8 {
#define PG8_LAS __attribute__((address_space(3)))
typedef unsigned short bf16_t;
typedef short bf16x8 __attribute__((ext_vector_type(8)));
typedef float f32x4 __attribute__((ext_vector_type(4)));
typedef unsigned u32x4 __attribute__((ext_vector_type(4)));
constexpr int BM = 256, BK = 64, HALF = 128, HTB = HALF * BK * 2  , STAGE_BYTES = 8 * HTB, NXCD = 8, WGM = 8;

__host__ __device__ __forceinline__ int lds_byte(int r, int c) { const int st = (r >> 4) * 2 + (c >> 5), rr = r & 15, cc = c & 31, ob = rr * 64 + cc * 2; return st * 1024 + (ob ^ (((ob >> 9) & 1) << 5)); }
__host__ __device__ __forceinline__ void stage_rc(int b, int& R, int& C) { const int st = b / 1024, sb = b % 1024, swz = sb ^ (((sb >> 9) & 1) << 5); R = (st >> 1) * 16 + swz / 64; C = (st & 1) * 32 + (swz % 64) / 2; }
__host__ __device__ __forceinline__ int perm32(int rho) { const int n = rho >> 4, i = rho & 15; return 8 * (i >> 2) + 4 * n + (i & 3); }

struct Unit { int pm, pn; };
struct Gemm { const bf16_t* A; const bf16_t* Bt; int M, N, K; };

struct StaticOrder {
    int nM, nN, nwg, G, c;
    __host__ __device__ void init(int M, int N, int G_, int c_) { nM = M / BM; nN = N / BM; nwg = nM * nN; G = G_; c = c_; }
    __host__ __device__ bool next(int i, Unit& u) const {
        const long L = (long)i * G + c; if (L >= nwg) return false;
        int wgid = (int)L; { const int q = nwg / NXCD, r = nwg % NXCD, xcd = wgid % NXCD, off = wgid / NXCD; wgid = (xcd < r ? xcd * (q + 1) : r * (q + 1) + (xcd - r) * q) + off; }
        const int nig = WGM * nN, gid = wgid / nig, fm = gid * WGM, gsz = (nM - fm) < WGM ? (nM - fm) : WGM;
        u.pm = fm + ((wgid % nig) % gsz); u.pn = (wgid % nig) / gsz; return true;
    }
    __device__ __forceinline__ void a_ready(const Unit&) const {}
    __device__ __forceinline__ void done(const Unit&) const {}
};

__device__ __forceinline__ unsigned cvt_pk_bf16(float lo, float hi) { unsigned r; asm volatile("v_cvt_pk_bf16_f32 %0, %1, %2" : "=v"(r) : "v"(lo), "v"(hi)); return r; }
__device__ __forceinline__ float ep_sigmoid(float x) { return __builtin_amdgcn_rcpf(1.0f + __expf(-x)); }
__device__ __forceinline__ float ep_lo(unsigned w) { return __uint_as_float(w << 16); }
__device__ __forceinline__ float ep_hi(unsigned w) { return __uint_as_float(w & 0xffff0000u); }
struct EpiB16 {
    static constexpr bool PERM = true, AFTER_DRAIN = false;
    bf16_t* O; int ldc;
    __device__ __forceinline__ void operator()(const f32x4 (&acc)[2][2][4][2], const Unit& u, int wr, int wc, int fr, int fq) const {
        const int row0 = u.pm * BM + wr * 64 + fr, col0 = u.pn * BM + wc * 32 + 8 * fq;
#pragma unroll
        for (int ai = 0; ai < 2; ++ai)
#pragma unroll
            for (int m = 0; m < 4; ++m) { bf16_t* rowp = O + (size_t)(row0 + ai * HALF + m * 16) * ldc + col0;
#pragma unroll
                for (int bj = 0; bj < 2; ++bj) { const f32x4 v0 = acc[ai][bj][m][0], v1 = acc[ai][bj][m][1];
                    u32x4 w; w.x = cvt_pk_bf16(v0[0], v0[1]); w.y = cvt_pk_bf16(v0[2], v0[3]); w.z = cvt_pk_bf16(v1[0], v1[1]); w.w = cvt_pk_bf16(v1[2], v1[3]);
                    *(u32x4*)(rowp + bj * HALF) = w; } }
    }
};
struct EpiF32o {
    static constexpr bool PERM = false, AFTER_DRAIN = false;
    float* C; int ldc;
    __device__ __forceinline__ void operator()(const f32x4 (&acc)[2][2][4][2], const Unit& u, int wr, int wc, int fr, int fq) const {
        const int row0 = u.pm * BM + wr * 64 + fr, col0 = u.pn * BM + wc * 32 + 4 * fq;
#pragma unroll
        for (int ai = 0; ai < 2; ++ai)
#pragma unroll
            for (int m = 0; m < 4; ++m) { float* rowp = C + (size_t)(row0 + ai * HALF + m * 16) * ldc + col0;
#pragma unroll
                for (int bj = 0; bj < 2; ++bj)
#pragma unroll
                    for (int n = 0; n < 2; ++n) *(f32x4*)(rowp + bj * HALF + n * 16) = acc[ai][bj][m][n]; }
    }
};
struct EpiSwiGlu {
    static constexpr bool PERM = true, AFTER_DRAIN = false;
    bf16_t* O; int ldc;
    __device__ __forceinline__ void operator()(const f32x4 (&acc)[2][2][4][2], const Unit& u, int wr, int wc, int fr, int fq) const {
        const int row0 = u.pm * BM + wr * 64 + fr, col0 = u.pn * HALF + wc * 32 + 8 * fq;
#pragma unroll
        for (int ai = 0; ai < 2; ++ai)
#pragma unroll
            for (int m = 0; m < 4; ++m) { bf16_t* rowp = O + (size_t)(row0 + ai * HALF + m * 16) * ldc + col0;
                float h[8];
#pragma unroll
                for (int n = 0; n < 2; ++n)
#pragma unroll
                    for (int j = 0; j < 4; ++j) { const float g = acc[ai][0][m][n][j], up = acc[ai][1][m][n][j]; h[4 * n + j] = g * ep_sigmoid(g) * up; }
                u32x4 w; w.x = cvt_pk_bf16(h[0], h[1]); w.y = cvt_pk_bf16(h[2], h[3]); w.z = cvt_pk_bf16(h[4], h[5]); w.w = cvt_pk_bf16(h[6], h[7]);
                *(u32x4*)rowp = w; }
    }
};
struct EpiGlu {
    static constexpr bool PERM = true, AFTER_DRAIN = false;
    const bf16_t* Y; int ldy; bf16_t* O; int ldo; int ocol0;
    __device__ __forceinline__ void operator()(const f32x4 (&acc)[2][2][4][2], const Unit& u, int wr, int wc, int fr, int fq) const {
        const int row0 = u.pm * BM + wr * 64 + fr, col0 = u.pn * BM + wc * 32 + 8 * fq;
#pragma unroll
        for (int ai = 0; ai < 2; ++ai)
#pragma unroll
            for (int m = 0; m < 4; ++m) { const size_t row = (size_t)(row0 + ai * HALF + m * 16);
#pragma unroll
                for (int bj = 0; bj < 2; ++bj) { const f32x4 v0 = acc[ai][bj][m][0], v1 = acc[ai][bj][m][1];
                    const u32x4 yv = *(const u32x4*)(Y + row * ldy + col0 + bj * HALF);
                    u32x4 w;
                    w.x = cvt_pk_bf16(ep_lo(yv.x) * ep_sigmoid(v0[0]), ep_hi(yv.x) * ep_sigmoid(v0[1]));
                    w.y = cvt_pk_bf16(ep_lo(yv.y) * ep_sigmoid(v0[2]), ep_hi(yv.y) * ep_sigmoid(v0[3]));
                    w.z = cvt_pk_bf16(ep_lo(yv.z) * ep_sigmoid(v1[0]), ep_hi(yv.z) * ep_sigmoid(v1[1]));
                    w.w = cvt_pk_bf16(ep_lo(yv.w) * ep_sigmoid(v1[2]), ep_hi(yv.w) * ep_sigmoid(v1[3]));
                    *(u32x4*)(O + row * ldo + ocol0 + col0 + bj * HALF) = w; } }
    }
};

template <class Epi, class Sched, bool ALIGN_EPI = false, bool SP2 = false>
__device__ __forceinline__ void gemm_phase(PG8_LAS unsigned char* lds, const Gemm g, const Sched& S, const Epi& E) {
    int tid_ = threadIdx.x; asm volatile("" : "+v"(tid_));   const int tid = tid_, wid = __builtin_amdgcn_readfirstlane(tid >> 6), lane = tid & 63, wr = wid >> 2, wc = wid & 3, fr = lane & 15, fq = lane >> 4;
    const int K = g.K, nt = K / BK;
    unsigned voffA[2], voffB[2];
#pragma unroll
    for (int i = 0; i < 2; ++i) { int R, C; stage_rc(tid * 16 + i * 8192, R, C); const int Rb = Epi::PERM ? ((R & ~31) + perm32(R & 31)) : R;
        voffA[i] = (unsigned)(R * K + C) * 2u; voffB[i] = (unsigned)(Rb * K + C) * 2u; }
    const size_t kstep = (size_t)(BK * 2);
    const size_t hstep = (size_t)HALF * K * 2;
    const size_t tstep = 2 * hstep;
    const unsigned ldsw = (unsigned)wid * 1024u;
    const int aoff = lds_byte(wr * 64 + fr, fq * 8), boff = lds_byte(wc * 32 + fr, fq * 8);
#define PG8_SA(b, h) (((b) * 2 + (h)) * HTB)
#define PG8_SB(b, h) ((4 + (b) * 2 + (h)) * HTB)
#define PG8_STAGE(bufoff, gbase, voff) do { _Pragma("unroll") for (int _i = 0; _i < 2; ++_i) \
        __builtin_amdgcn_global_load_lds((const unsigned*)((const char*)(gbase) + (voff)[_i]), (PG8_LAS unsigned*)(lds + (bufoff) + ldsw + _i * 8192), 16, 0, 0); } while (0)
#define PG8_LDA(dst, b, h) do { _Pragma("unroll") for (int m = 0; m < 4; ++m) _Pragma("unroll") for (int k = 0; k < 2; ++k) dst[m][k] = *(const PG8_LAS bf16x8*)(lds + PG8_SA(b, h) + aoff + m * 2048 + k * 1024); } while (0)
#define PG8_LDB(dst, b, h) do { _Pragma("unroll") for (int n = 0; n < 2; ++n) _Pragma("unroll") for (int k = 0; k < 2; ++k) dst[n][k] = *(const PG8_LAS bf16x8*)(lds + PG8_SB(b, h) + boff + n * 2048 + k * 1024); } while (0)
#define PG8_MMA(ai, bj, At, Bt) do { __builtin_amdgcn_s_setprio(1); _Pragma("unroll") for (int m = 0; m < 4; ++m) _Pragma("unroll") for (int n = 0; n < 2; ++n) _Pragma("unroll") for (int k = 0; k < 2; ++k) \
        acc[ai][bj][m][n] = __builtin_amdgcn_mfma_f32_16x16x32_bf16(Bt[n][k], At[m][k], acc[ai][bj][m][n], 0, 0, 0); __builtin_amdgcn_s_setprio(0); } while (0)
#define PG8_WAIT_V(n) asm volatile("s_waitcnt vmcnt(" #n ")" ::: "memory")
#define PG8_WAIT_L(n) asm volatile("s_waitcnt lgkmcnt(" #n ")" ::: "memory")
#define PG8_BAR __builtin_amdgcn_s_barrier()
#define PG8_SCHED __builtin_amdgcn_sched_barrier(0)
    Unit cur, nxt; int ui = 0;
    if (!S.next(0, cur)) return;
    f32x4 acc[2][2][4][2];
#pragma unroll
    for (int a = 0; a < 2; ++a)
#pragma unroll
        for (int b = 0; b < 2; ++b)
#pragma unroll
            for (int m = 0; m < 4; ++m)
#pragma unroll
                for (int n = 0; n < 2; ++n) acc[a][b][m][n] = (f32x4){0.f, 0.f, 0.f, 0.f};
    bf16x8 At[4][2], B0[2][2], B1[2][2];
    const char* cA = (const char*)g.A + (size_t)cur.pm * tstep; const char* cB = (const char*)g.Bt + (size_t)cur.pn * tstep;
    S.a_ready(cur);
    if constexpr (SP2) {
        PG8_STAGE(PG8_SB(0, 0), cB, voffB); PG8_STAGE(PG8_SB(0, 1), cB + hstep, voffB); PG8_STAGE(PG8_SA(0, 0), cA, voffA); PG8_STAGE(PG8_SA(0, 1), cA + hstep, voffA);
        if (wr == 1) PG8_BAR;
        PG8_WAIT_V(2); PG8_BAR;
        PG8_STAGE(PG8_SB(1, 0), cB + kstep, voffB); PG8_STAGE(PG8_SA(1, 0), cA + kstep, voffA); PG8_STAGE(PG8_SB(1, 1), cB + hstep + kstep, voffB);
        PG8_WAIT_V(6); PG8_BAR;
    } else {
        PG8_STAGE(PG8_SB(0, 0), cB, voffB); PG8_STAGE(PG8_SA(0, 0), cA, voffA); PG8_STAGE(PG8_SB(0, 1), cB + hstep, voffB); PG8_STAGE(PG8_SA(0, 1), cA + hstep, voffA);
        if (wr == 1) PG8_BAR;
        PG8_WAIT_V(4); PG8_BAR;
        PG8_STAGE(PG8_SB(1, 0), cB + kstep, voffB); PG8_STAGE(PG8_SA(1, 0), cA + kstep, voffA); PG8_STAGE(PG8_SB(1, 1), cB + hstep + kstep, voffB);
        PG8_WAIT_V(6); PG8_BAR;
    }
    for (;;) {
        const bool has_next = S.next(ui + 1, nxt);
        const char* nA = has_next ? (const char*)g.A + (size_t)nxt.pm * tstep : cA; const char* nB = has_next ? (const char*)g.Bt + (size_t)nxt.pn * tstep : cB;
        for (int t = 0; t < nt; t += 2) {
            const bool last = (t == nt - 2);
            const char* a1 = cA + (size_t)(t + 1) * kstep;
            const char* a2 = last ? nA : cA + (size_t)(t + 2) * kstep; const char* b2 = last ? nB : cB + (size_t)(t + 2) * kstep;
            const char* a3 = a2 + kstep; const char* b3 = b2 + kstep;
            if (last && has_next) S.a_ready(nxt);
            if constexpr (SP2) {
            PG8_LDB(B0, 0, 0); PG8_LDB(B1, 0, 1); PG8_SCHED; PG8_LDA(At, 0, 0); PG8_STAGE(PG8_SA(1, 1), a1 + hstep, voffA);
            PG8_WAIT_V(8); PG8_WAIT_L(0); PG8_BAR; PG8_MMA(0, 0, At, B0); PG8_MMA(0, 1, At, B1); PG8_BAR; PG8_SCHED;
            PG8_LDA(At, 0, 1); PG8_STAGE(PG8_SB(0, 0), b2, voffB); PG8_STAGE(PG8_SB(0, 1), b2 + hstep, voffB); PG8_STAGE(PG8_SA(0, 0), a2, voffA);
            PG8_WAIT_V(8); PG8_WAIT_L(0); PG8_BAR; PG8_MMA(1, 0, At, B0); PG8_MMA(1, 1, At, B1); PG8_BAR; PG8_SCHED;
            PG8_LDB(B0, 1, 0); PG8_LDB(B1, 1, 1); PG8_SCHED; PG8_LDA(At, 1, 0); PG8_STAGE(PG8_SA(0, 1), a2 + hstep, voffA);
            PG8_WAIT_V(8); PG8_WAIT_L(0); PG8_BAR; PG8_MMA(0, 0, At, B0); PG8_MMA(0, 1, At, B1); PG8_BAR; PG8_SCHED;
            PG8_LDA(At, 1, 1); PG8_STAGE(PG8_SB(1, 0), b3, voffB); PG8_STAGE(PG8_SB(1, 1), b3 + hstep, voffB); PG8_STAGE(PG8_SA(1, 0), a3, voffA);
            PG8_WAIT_V(8); PG8_WAIT_L(0); PG8_BAR; PG8_MMA(1, 0, At, B0); PG8_MMA(1, 1, At, B1); PG8_BAR; PG8_SCHED;
            } else {
            PG8_LDB(B0, 0, 0); PG8_SCHED; PG8_LDA(At, 0, 0); PG8_STAGE(PG8_SA(1, 1), a1 + hstep, voffA);
            PG8_WAIT_L(8); PG8_BAR; PG8_WAIT_L(0); PG8_MMA(0, 0, At, B0); PG8_BAR; PG8_SCHED;
            PG8_LDB(B1, 0, 1); PG8_STAGE(PG8_SB(0, 0), b2, voffB);
            PG8_BAR; PG8_WAIT_L(0); PG8_MMA(0, 1, At, B1); PG8_BAR;
            PG8_LDA(At, 0, 1); PG8_STAGE(PG8_SA(0, 0), a2, voffA);
            PG8_BAR; PG8_WAIT_L(0); PG8_MMA(1, 0, At, B0); PG8_BAR; PG8_SCHED;
            PG8_STAGE(PG8_SB(0, 1), b2 + hstep, voffB);
            PG8_WAIT_V(6); PG8_BAR; PG8_MMA(1, 1, At, B1); PG8_BAR;
            PG8_LDB(B0, 1, 0); PG8_SCHED; PG8_LDA(At, 1, 0); PG8_STAGE(PG8_SA(0, 1), a2 + hstep, voffA);
            PG8_WAIT_L(8); PG8_BAR; PG8_WAIT_L(0); PG8_MMA(0, 0, At, B0); PG8_BAR; PG8_SCHED;
            PG8_LDB(B1, 1, 1); PG8_STAGE(PG8_SB(1, 0), b3, voffB);
            PG8_BAR; PG8_WAIT_L(0); PG8_MMA(0, 1, At, B1); PG8_BAR;
            PG8_LDA(At, 1, 1); PG8_STAGE(PG8_SA(1, 0), a3, voffA);
            PG8_BAR; PG8_WAIT_L(0); PG8_MMA(1, 0, At, B0); PG8_BAR; PG8_SCHED;
            PG8_STAGE(PG8_SB(1, 1), b3 + hstep, voffB);
            PG8_WAIT_V(6); PG8_BAR; PG8_MMA(1, 1, At, B1); PG8_BAR;
            }
        }
        if constexpr (ALIGN_EPI) { if (wr == 0) PG8_BAR; }
        if constexpr (!Epi::AFTER_DRAIN) { E(acc, cur, wr, wc, fr, fq); S.done(cur); }
        if (!has_next) break;
#pragma unroll
        for (int a = 0; a < 2; ++a)
#pragma unroll
            for (int b = 0; b < 2; ++b)
#pragma unroll
                for (int m = 0; m < 4; ++m)
#pragma unroll
                    for (int n = 0; n < 2; ++n) acc[a][b][m][n] = (f32x4){0.f, 0.f, 0.f, 0.f};
        cur = nxt; cA = nA; cB = nB; ++ui;
        if constexpr (ALIGN_EPI) { if (wr == 1) PG8_BAR; }
    }
    PG8_WAIT_V(0);
    if constexpr (!ALIGN_EPI) { if (wr == 0) PG8_BAR; }
    PG8_BAR;
    if constexpr (Epi::AFTER_DRAIN) { E.fused(acc, cur, wr, wc, fr, fq, lds, wid, lane); S.done(cur); }
#undef PG8_SA
#undef PG8_SB
#undef PG8_STAGE
#undef PG8_LDA
#undef PG8_LDB
#undef PG8_MMA
#undef PG8_WAIT_V
#undef PG8_WAIT_L
#undef PG8_BAR
#undef PG8_SCHED
}
}
#define GAS __attribute__((address_space(1)))
#define LAS __attribute__((address_space(3)))
typedef unsigned short bf16;
typedef unsigned v4u __attribute__((ext_vector_type(4)));
typedef unsigned v2u __attribute__((ext_vector_type(2)));
typedef float f32x4 __attribute__((ext_vector_type(4)));
typedef float f32x2 __attribute__((ext_vector_type(2)));
typedef short bf16x8 __attribute__((ext_vector_type(8)));
#define LDS_WAIT() asm volatile("s_waitcnt lgkmcnt(0)" ::: "memory")
__device__ __forceinline__ unsigned f2bf(float f) { unsigned u = __builtin_bit_cast(unsigned, f); return (u + 0x7fffu + ((u >> 16) & 1u)) >> 16; }
__device__ __forceinline__ unsigned pk2(float lo, float hi) { return f2bf(lo) | (f2bf(hi) << 16); }
__device__ __forceinline__ float bf2f(unsigned short b) { return __uint_as_float(((unsigned)b) << 16); }
__device__ __forceinline__ float lo_bf(unsigned w) { return __uint_as_float(w << 16); }
__device__ __forceinline__ float hi_bf(unsigned w) { return __uint_as_float(w & 0xffff0000u); }
__device__ __forceinline__ float wave_sum(float v) {
#pragma unroll
    for (int o = 1; o < 64; o <<= 1) v += __shfl_xor(v, o);
    return v;
}
__device__ __forceinline__ float sigmoid_f(float x) { return 1.0f / (1.0f + __expf(-x)); }
__device__ __forceinline__ float silu_f(float x) { return x / (1.0f + __expf(-x)); }
__device__ __forceinline__ f32x4 mfma16(bf16x8 a, bf16x8 b, f32x4 c) { return __builtin_amdgcn_mfma_f32_16x16x32_bf16(a, b, c, 0, 0, 0); }
#define XB_TMO      128
#define XB_XCNT(j)  (256  + 64 * (j))
#define XB_XSUB(j)  (1280 + 64 * (j))
#define XB_XGEN(j)  (2304 + 64 * (j))
#define XB_TOP      3328
#define XB_TOPGEN   3392
#define XCD_BAR_WORDS 3456
#define XB_SPIN_CAP (1u << 18)

__device__ __forceinline__ unsigned xb_ld(unsigned* p)              { return __hip_atomic_load(p, __ATOMIC_RELAXED, __HIP_MEMORY_SCOPE_AGENT); }
__device__ __forceinline__ unsigned xb_add(unsigned* p, unsigned v) { return __hip_atomic_fetch_add(p, v, __ATOMIC_RELAXED, __HIP_MEMORY_SCOPE_AGENT); }
__device__ __forceinline__ unsigned xb_xcc_id() { return (unsigned)__builtin_amdgcn_s_getreg((3 << 11) | 20) & 0xFu; }
#define XB_SPIN(cond, bar) do { unsigned _sp = 0; while (cond) { __builtin_amdgcn_s_sleep(1); \
    if ((++_sp & 255u) == 0u) { if (xb_ld(&(bar)[XB_TMO])) break; if (_sp > XB_SPIN_CAP) { atomicAdd(&(bar)[XB_TMO], 1u); break; } } } } while (0)

struct XcdBarrier {
    unsigned* bar; unsigned x;
    volatile LAS unsigned* st;
};

__device__ __forceinline__ XcdBarrier xcd_barrier_post(unsigned* bar, volatile LAS unsigned* st) {
    XcdBarrier b; b.bar = bar; b.x = xb_xcc_id(); b.st = st;
    if (threadIdx.x == 0) (void)xb_add(&bar[XB_XCNT(b.x)], 1u);
    return b;
}
__device__ __forceinline__ void xcd_barrier_complete(unsigned* bar, unsigned x, unsigned& nloc, unsigned& nx) {
    const unsigned G = gridDim.x * gridDim.y * gridDim.z;
    unsigned sum, cnt, mine, sp = 0u;
    for (;;) {
        sum = 0u; cnt = 0u; mine = 0u;
#pragma unroll
        for (unsigned j = 0; j < 16; ++j) { const unsigned c = xb_ld(&bar[XB_XCNT(j)]); sum += c; cnt += (c > 0u) ? 1u : 0u; mine = (j == x) ? c : mine; }
        if (sum == G) break;
        __builtin_amdgcn_s_sleep(1);
        if ((++sp & 255u) == 0u) { if (xb_ld(&bar[XB_TMO])) break; if (sp > XB_SPIN_CAP) { atomicAdd(&bar[XB_TMO], 1u); break; } }
    }
    nloc = mine > 0u ? mine : 1u; nx = cnt > 0u ? cnt : 1u;
}

__device__ __forceinline__ void xcd_barrier(const XcdBarrier& b) {
    asm volatile("s_waitcnt vmcnt(0)" ::: "memory");
    __syncthreads();
    if (threadIdx.x == 0) {
        unsigned* bar = b.bar;
        __builtin_amdgcn_s_waitcnt(0);
        unsigned nloc = b.st[0], nx = b.st[1];
        if (nloc == 0u) { xcd_barrier_complete(bar, b.x, nloc, nx); b.st[0] = nloc; b.st[1] = nx; }
        const unsigned old = xb_add(&bar[XB_XSUB(b.x)], 1u);
        const unsigned gen = old / nloc;
        if (old + 1u == (gen + 1u) * nloc) {
            __builtin_amdgcn_fence(__ATOMIC_RELEASE, "agent");
            asm volatile("s_waitcnt vmcnt(0)" ::: "memory");
            const unsigned og = xb_add(&bar[XB_TOP], 1u);
            const unsigned tg = og / nx;
            if (og + 1u == (tg + 1u) * nx) xb_add(&bar[XB_TOPGEN], 1u);
            else XB_SPIN(xb_ld(&bar[XB_TOPGEN]) == tg, bar);
            __builtin_amdgcn_fence(__ATOMIC_ACQUIRE, "agent");
            xb_add(&bar[XB_XGEN(b.x)], 1u);
            asm volatile("s_waitcnt vmcnt(0)" ::: "memory");
        } else {
            XB_SPIN(xb_ld(&bar[XB_XGEN(b.x)]) == gen, bar);
            __builtin_amdgcn_fence(__ATOMIC_ACQUIRE, "agent");
            asm volatile("s_waitcnt vmcnt(0)" ::: "memory");
        }
    }
    __syncthreads();
}

constexpr int BATCH = 4, SEQ = 2048, DM = 2048, MTOK = BATCH * SEQ, DFF = 5632, PLD = 6144, NIN_E = 5376, NIN_O = 6144;
constexpr int NPH = 34;
constexpr float ALPHA_DN = 1.6817928305074290f;
constexpr float LN_EPS = 1e-5f;
constexpr float LOG2E = 1.4426950408889634f;
constexpr size_t MiB = 1u << 20;
constexpr size_t WS_CTL = 0, CTL_ZERO_BYTES = 1 * MiB;
constexpr size_t WS_WIN = 2 * MiB, WIN_STRIDE = 24 * MiB;
constexpr size_t WS_WOUT = 98 * MiB, WOUT_STRIDE = 8 * MiB;
constexpr size_t WS_WGLU = 130 * MiB, WGLU_STRIDE = 2 * MiB;
constexpr size_t WS_WGU = 134 * MiB, WGU_STRIDE = 44 * MiB;
constexpr size_t WS_WDN = 310 * MiB, WDN_STRIDE = 22 * MiB;
constexpr size_t WS_X = 398 * MiB;
constexpr size_t WS_H = 462 * MiB;
constexpr size_t WS_PROJ = 494 * MiB;
constexpr size_t WS_MIX = 590 * MiB;
constexpr size_t WS_Y = 622 * MiB;
constexpr size_t WS_HID = 686 * MiB;
constexpr size_t WS_MOD = 774 * MiB;
constexpr size_t WS_YPRE = 775 * MiB;
constexpr size_t WS_ODN = 791 * MiB;
constexpr size_t WS_CHU = 823 * MiB, WS_CHW = 839 * MiB, WS_CHQD = 855 * MiB, WS_CHKT = 871 * MiB;
constexpr size_t WS_CHA = 887 * MiB;
constexpr size_t WS_CHGL = 895 * MiB;
constexpr size_t WS_S5END = 896 * MiB;
constexpr size_t WS_END = 897 * MiB;
constexpr int CW_BAR = 4096;
constexpr int LDS_BYTES = 147456, LDS_MISC = 143360;

struct Args { const float* in[34]; float* out; unsigned char* ws; int ph_lo, ph_hi; };

__device__ __forceinline__ int dest_row(int mode, int n) {
    if (mode == 1) return n < 4096 ? n : (n < 4112 ? n + 1024 : n - 16);
    if (mode == 2) return ((n >> 7) << 8) + (n & 127);
    if (mode == 3) return ((n >> 7) << 8) + 128 + (n & 127);
    return n;
}
__device__ __forceinline__ void transpose_item(const float* __restrict__ W, int K, int N, bf16* WT, int mode, LAS float* scr, int kb, int nb, int lane) {
    const int k0 = kb * 64, n0 = nb * 64, cq = lane & 15, rq = lane >> 4, n = n0 + 4 * cq;
#pragma unroll 4
    for (int i = 0; i < 16; ++i) { const int kk = 4 * i + rq; f32x4 v = (f32x4){0.f, 0.f, 0.f, 0.f};
        if (n < N) v = *(const f32x4*)(W + (size_t)(k0 + kk) * N + n);
        LAS float* s = scr + kk * 65 + 4 * cq; s[0] = v.x; s[1] = v.y; s[2] = v.z; s[3] = v.w; }
    LDS_WAIT();
    const int c = lane & 7;
#pragma unroll
    for (int j = 0; j < 8; ++j) { const int nn = 8 * j + (lane >> 3), ng = n0 + nn;
        if (ng < N) { const LAS float* s = scr + (8 * c) * 65 + nn;
            v4u o; o.x = pk2(s[0], s[65]); o.y = pk2(s[130], s[195]); o.z = pk2(s[260], s[325]); o.w = pk2(s[390], s[455]);
            *(v4u*)(WT + (size_t)dest_row(mode, ng) * K + k0 + 8 * c) = o; } }
    LDS_WAIT();
}
__device__ __forceinline__ void p0a_phase(LAS unsigned char* lds, const Args& A, int G) {
    int tid_ = threadIdx.x; asm volatile("" : "+v"(tid_)); const int tid = tid_, lane = tid & 63, wave = __builtin_amdgcn_readfirstlane(tid >> 6);
    unsigned char* ws = A.ws;
    {
        LAS float* cact = (LAS float*)lds;
        LAS float* red = (LAS float*)(lds + 32768);
        const float* c = A.in[1]; const float* ada_w = A.in[2]; const float* ada_b = A.in[3]; float* MOD = (float*)(ws + WS_MOD);
        for (int e = tid; e < 4 * 2048; e += 512) { const float cv = c[e]; cact[e] = cv / (1.0f + expf(-cv)); }
        __syncthreads();
        for (int it = blockIdx.x; it < 192; it += G) {
            const int layer = it / 48, cg = it % 48;
            const float* Wl = ada_w + (size_t)layer * 2048 * 12288 + cg * 256 + 4 * lane;
            f32x4 acc[4];
#pragma unroll
            for (int b = 0; b < 4; ++b) acc[b] = (f32x4){0.f, 0.f, 0.f, 0.f};
            const int kbeg = wave * 256;
#pragma unroll 2
            for (int k = kbeg; k < kbeg + 256; k += 4) {
                const f32x4 w0 = *(const f32x4*)(Wl + (size_t)(k + 0) * 12288), w1 = *(const f32x4*)(Wl + (size_t)(k + 1) * 12288);
                const f32x4 w2 = *(const f32x4*)(Wl + (size_t)(k + 2) * 12288), w3 = *(const f32x4*)(Wl + (size_t)(k + 3) * 12288);
#pragma unroll
                for (int b = 0; b < 4; ++b) { const f32x4 cv = *(const LAS f32x4*)(cact + b * 2048 + k); acc[b] += cv.x * w0 + cv.y * w1 + cv.z * w2 + cv.w * w3; }
            }
#pragma unroll
            for (int b = 0; b < 4; ++b) *(LAS f32x4*)(red + (wave * 4 + b) * 256 + 4 * lane) = acc[b];
            __syncthreads();
            { const int b = tid >> 7, c0 = 2 * (tid & 127); float s0 = 0.f, s1 = 0.f;
#pragma unroll
              for (int w = 0; w < 8; ++w) { s0 += red[(w * 4 + b) * 256 + c0]; s1 += red[(w * 4 + b) * 256 + c0 + 1]; }
              const int col = cg * 256 + c0;
              MOD[(size_t)(layer * 4 + b) * 12288 + col] = s0 + ada_b[layer * 12288 + col];
              MOD[(size_t)(layer * 4 + b) * 12288 + col + 1] = s1 + ada_b[layer * 12288 + col + 1]; }
            __syncthreads();
        }
    }
    {
        LAS float* scr = (LAS float*)(lds + wave * 16896);
        const int gw = blockIdx.x * 8 + wave, NGW = G * 8;
        constexpr int I_FF = 32 * 88, I_ABI = 32 * 81, I_CDI = 32 * 96, I_OUT = 32 * 32, I_GLU = 16 * 16;
        constexpr int NITEMS = 12 * I_FF + 2 * I_ABI + 2 * I_CDI + 4 * I_OUT + 2 * I_GLU;
        for (int it = gw; it < NITEMS; it += NGW) {
            int r = it;
            const float* W; int K, N, mode, NB; bf16* WT;
            if (r < 4 * I_FF) { const int l = r / I_FF; r -= l * I_FF; W = A.in[8] + (size_t)l * 2048 * DFF; K = 2048; N = DFF; mode = 2; NB = 88; WT = (bf16*)(ws + WS_WGU + l * WGU_STRIDE); }
            else if ((r -= 4 * I_FF) < 4 * I_FF) { const int l = r / I_FF; r -= l * I_FF; W = A.in[9] + (size_t)l * 2048 * DFF; K = 2048; N = DFF; mode = 3; NB = 88; WT = (bf16*)(ws + WS_WGU + l * WGU_STRIDE); }
            else if ((r -= 4 * I_FF) < 4 * I_FF) { const int l = r / I_FF; r -= l * I_FF; W = A.in[10] + (size_t)l * DFF * 2048; K = DFF; N = 2048; mode = 0; NB = 32; WT = (bf16*)(ws + WS_WDN + l * WDN_STRIDE); }
            else if ((r -= 4 * I_FF) < 2 * I_ABI) { const int j = r / I_ABI; r -= j * I_ABI; W = A.in[11] + (size_t)j * 2048 * 5136; K = 2048; N = 5136; mode = 1; NB = 81; WT = (bf16*)(ws + WS_WIN + (2 * j) * WIN_STRIDE); }
            else if ((r -= 2 * I_ABI) < 2 * I_CDI) { const int j = r / I_CDI; r -= j * I_CDI; W = A.in[26] + (size_t)j * 2048 * 6144; K = 2048; N = 6144; mode = 0; NB = 96; WT = (bf16*)(ws + WS_WIN + (2 * j + 1) * WIN_STRIDE); }
            else if ((r -= 2 * I_CDI) < 2 * I_OUT) { const int j = r / I_OUT; r -= j * I_OUT; W = A.in[12] + (size_t)j * 2048 * 2048; K = 2048; N = 2048; mode = 0; NB = 32; WT = (bf16*)(ws + WS_WOUT + (2 * j) * WOUT_STRIDE); }
            else if ((r -= 2 * I_OUT) < 2 * I_OUT) { const int j = r / I_OUT; r -= j * I_OUT; W = A.in[27] + (size_t)j * 2048 * 2048; K = 2048; N = 2048; mode = 0; NB = 32; WT = (bf16*)(ws + WS_WOUT + (2 * j + 1) * WOUT_STRIDE); }
            else { r -= 2 * I_OUT; const int j = r / I_GLU; r -= j * I_GLU; W = A.in[25] + (size_t)j * 1024 * 1024; K = 1024; N = 1024; mode = 0; NB = 16; WT = (bf16*)(ws + WS_WGLU + j * WGLU_STRIDE); }
            transpose_item(W, K, N, WT, mode, scr, r / NB, r % NB, lane);
        }
    }
}
__device__ __forceinline__ void modulate_phase(const float* X, const float* MODl  , int sh_off, int sc_off, bf16* H, int G) {
    const size_t nth = (size_t)G * 512;
    int tid_ = threadIdx.x; asm volatile("" : "+v"(tid_));
    for (size_t e = (size_t)blockIdx.x * 512 + tid_; e < (size_t)MTOK * DM / 8; e += nth) {
        const int m = (int)(e >> 8), c8 = (int)(e & 255) * 8, b = m >> 11;
        const f32x4 x0 = *(const f32x4*)(X + (size_t)m * DM + c8), x1 = *(const f32x4*)(X + (size_t)m * DM + c8 + 4);
        const float* mb = MODl + (size_t)b * 12288;
        const f32x4 s0 = *(const f32x4*)(mb + sc_off + c8), s1 = *(const f32x4*)(mb + sc_off + c8 + 4);
        const f32x4 h0 = *(const f32x4*)(mb + sh_off + c8), h1 = *(const f32x4*)(mb + sh_off + c8 + 4);
        const f32x4 o0 = x0 * (1.0f + s0) + h0, o1 = x1 * (1.0f + s1) + h1;
        v4u w; w.x = pk2(o0.x, o0.y); w.y = pk2(o0.z, o0.w); w.z = pk2(o1.x, o1.y); w.w = pk2(o1.z, o1.w);
        *(v4u*)(H + (size_t)m * DM + c8) = w;
    }
}
__device__ __forceinline__ void ln_phase(const float* Xin, const float* Y, float* Xout, bf16* H, const float* MODg  ,
                                         const float* lng, const float* lnb, const float* MODn  , int sh_off, int sc_off, int G) {
    int tid_ = threadIdx.x; asm volatile("" : "+v"(tid_)); const int lane = tid_ & 63, gw = blockIdx.x * 8 + (tid_ >> 6), NGW = G * 8;
    for (int m = gw; m < MTOK; m += NGW) {
        const int b = m >> 11;
        const float* xr = Xin + (size_t)m * DM + 4 * lane; const float* yr = Y + (size_t)m * DM + 4 * lane; const float* gr = MODg + (size_t)b * 12288 + 4 * lane;
        f32x4 v[8]; float s = 0.f;
#pragma unroll
        for (int j = 0; j < 8; ++j) { const f32x4 x = *(const f32x4*)(xr + 256 * j), y = *(const f32x4*)(yr + 256 * j), g = *(const f32x4*)(gr + 256 * j);
            v[j] = ALPHA_DN * x + (1.0f + g) * y; s += (v[j].x + v[j].y) + (v[j].z + v[j].w); }
        const float mean = wave_sum(s) * (1.0f / DM); float s2 = 0.f;
#pragma unroll
        for (int j = 0; j < 8; ++j) { v[j] = v[j] - mean; s2 += (v[j].x * v[j].x + v[j].y * v[j].y) + (v[j].z * v[j].z + v[j].w * v[j].w); }
        const float rstd = 1.0f / sqrtf(wave_sum(s2) * (1.0f / DM) + LN_EPS);
#pragma unroll
        for (int j = 0; j < 8; ++j) { const int col = 4 * lane + 256 * j;
            const f32x4 o = v[j] * rstd * *(const f32x4*)(lng + col) + *(const f32x4*)(lnb + col);
            *(f32x4*)(Xout + (size_t)m * DM + col) = o;
            if (MODn) { const float* mb = MODn + (size_t)b * 12288 + col; const f32x4 hh = o * (1.0f + *(const f32x4*)(mb + sc_off)) + *(const f32x4*)(mb + sh_off);
                v2u w; w.x = pk2(hh.x, hh.y); w.y = pk2(hh.z, hh.w); *(v2u*)(H + (size_t)m * DM + col) = w; } }
    }
}

__device__ __forceinline__ void shortconv_phase(const bf16* PROJ, const float* cw  , bf16* MIX, int G) {
    const size_t nth = (size_t)G * 512;
    int tid_ = threadIdx.x; asm volatile("" : "+v"(tid_));
    for (size_t e = (size_t)blockIdx.x * 512 + tid_; e < (size_t)MTOK * 128; e += nth) {
        const int m = (int)(e >> 7), c8 = (int)(e & 127) * 8, t = m & (SEQ - 1);
        float acc[8];
#pragma unroll
        for (int i = 0; i < 8; ++i) acc[i] = 0.f;
#pragma unroll
        for (int kk = 0; kk < 3; ++kk) {
            if (t - 2 + kk >= 0) {
                const bf16* row = PROJ + (size_t)(m - 2 + kk) * PLD;
                const v4u g = *(const v4u*)(row + 1024 + c8), x = *(const v4u*)(row + 2048 + c8);
                const f32x4 w0 = *(const f32x4*)(cw + kk * 1024 + c8), w1 = *(const f32x4*)(cw + kk * 1024 + c8 + 4);
                acc[0] += w0.x * lo_bf(g.x) * lo_bf(x.x); acc[1] += w0.y * hi_bf(g.x) * hi_bf(x.x);
                acc[2] += w0.z * lo_bf(g.y) * lo_bf(x.y); acc[3] += w0.w * hi_bf(g.y) * hi_bf(x.y);
                acc[4] += w1.x * lo_bf(g.z) * lo_bf(x.z); acc[5] += w1.y * hi_bf(g.z) * hi_bf(x.z);
                acc[6] += w1.z * lo_bf(g.w) * lo_bf(x.w); acc[7] += w1.w * hi_bf(g.w) * hi_bf(x.w);
            }
        }
        const v4u gb = *(const v4u*)(PROJ + (size_t)m * PLD + c8);
        v4u w; w.x = pk2(lo_bf(gb.x) * acc[0], hi_bf(gb.x) * acc[1]); w.y = pk2(lo_bf(gb.y) * acc[2], hi_bf(gb.y) * acc[3]);
        w.z = pk2(lo_bf(gb.z) * acc[4], hi_bf(gb.z) * acc[5]); w.w = pk2(lo_bf(gb.w) * acc[6], hi_bf(gb.w) * acc[7]);
        *(v4u*)(MIX + (size_t)m * DM + c8) = w;
    }
}

__device__ __forceinline__ void attn_phase(LAS unsigned char* lds, const bf16* PROJ, bf16* MIX, const float* lq1, const float* lk1, const float* lq2, const float* lk2,
                                           const float* norm_g, float lambda_init, int G) {
    int tid_ = threadIdx.x; asm volatile("" : "+v"(tid_)); const int tid = tid_, lane = tid & 63, w = __builtin_amdgcn_readfirstlane(tid >> 6), q4 = lane >> 4, l15 = lane & 15, mi = w >> 2, wq = w & 3;
    float lam;
    { float s1 = lq1[lane] * lk1[lane] + lq1[lane + 64] * lk1[lane + 64], s2 = lq2[lane] * lk2[lane] + lq2[lane + 64] * lk2[lane + 64];
      s1 = wave_sum(s1); s2 = wave_sum(s2); lam = expf(s1) - expf(s2) + lambda_init; }
    LAS unsigned char* K0 = lds; LAS unsigned char* K1 = lds + 17408; LAS unsigned char* VT = lds + 34816; LAS unsigned char* XCH = lds;
    LAS unsigned char* Kmine = mi ? K1 : K0;
    const float c1 = 0.08838834764831845f * LOG2E;
    for (int u = blockIdx.x; u < 256; u += G) {
        const int b = u >> 6, h = (u >> 4) & 3, p = u & 15;
        const float sl2 = exp2f(-2.0f * (float)(h + 1)) * LOG2E;
        const bf16* base = PROJ + (size_t)b * SEQ * PLD;
        for (int half = 0; half < 2; ++half) {
            const int qb = half ? 31 - p : p;
            const int qloc = 16 * wq + l15;
            bf16x8 qf[4];
            { const bf16* qp = base + (size_t)(64 * qb + qloc) * PLD + 3072 + h * 256 + mi * 128 + 8 * q4;
#pragma unroll
              for (int sk = 0; sk < 4; ++sk) qf[sk] = *(const bf16x8*)(qp + 32 * sk); }
            f32x4 O[16];
#pragma unroll
            for (int mt = 0; mt < 16; ++mt) O[mt] = (f32x4){0.f, 0.f, 0.f, 0.f};
            float m_run = -1e30f, l_part = 0.f;
            v4u rk0[2], rk1[2], rv[4];
#define ATT_LOAD(kt_) do { const bf16* tb = base + (size_t)(64 * (kt_)) * PLD + h * 256; \
                _Pragma("unroll") for (int j = 0; j < 2; ++j) { const int c = tid + 512 * j, key = c >> 4, ch = c & 15; \
                    rk0[j] = *(const v4u*)(tb + (size_t)key * PLD + 4096 + 8 * ch); rk1[j] = *(const v4u*)(tb + (size_t)key * PLD + 4096 + 128 + 8 * ch); } \
                _Pragma("unroll") for (int j = 0; j < 4; ++j) { const int c = tid + 512 * j, key = c >> 5, ch = c & 31; rv[j] = *(const v4u*)(tb + (size_t)key * PLD + 5120 + 8 * ch); } } while (0)
            ATT_LOAD(0);
            for (int kt = 0; kt <= qb; ++kt) {
                __syncthreads();
#pragma unroll
                for (int j = 0; j < 2; ++j) { const int c = tid + 512 * j, key = c >> 4, ch = c & 15;
                    *(LAS v4u*)(K0 + key * 272 + ch * 16) = rk0[j]; *(LAS v4u*)(K1 + key * 272 + ch * 16) = rk1[j]; }
#pragma unroll
                for (int j = 0; j < 4; ++j) { const int c = tid + 512 * j, key = c >> 5, ch = c & 31;
                    LAS unsigned short* vp = (LAS unsigned short*)VT + (8 * ch) * 72 + key;
                    vp[0 * 72] = (unsigned short)(rv[j].x & 0xffffu); vp[1 * 72] = (unsigned short)(rv[j].x >> 16);
                    vp[2 * 72] = (unsigned short)(rv[j].y & 0xffffu); vp[3 * 72] = (unsigned short)(rv[j].y >> 16);
                    vp[4 * 72] = (unsigned short)(rv[j].z & 0xffffu); vp[5 * 72] = (unsigned short)(rv[j].z >> 16);
                    vp[6 * 72] = (unsigned short)(rv[j].w & 0xffffu); vp[7 * 72] = (unsigned short)(rv[j].w >> 16); }
                __syncthreads();
                if (kt < qb) ATT_LOAD(kt + 1);
                f32x4 s[4];
#pragma unroll
                for (int t16 = 0; t16 < 4; ++t16) { f32x4 acc = (f32x4){0.f, 0.f, 0.f, 0.f};
#pragma unroll
                    for (int sk = 0; sk < 4; ++sk) { const bf16x8 a = *(const LAS bf16x8*)(Kmine + (16 * t16 + l15) * 272 + (32 * sk + 8 * q4) * 2); acc = mfma16(a, qf[sk], acc); }
                    s[t16] = acc; }
                const int dq = 64 * (qb - kt) + qloc; const bool diag = (kt == qb);
                float mx = -1e30f;
#pragma unroll
                for (int t16 = 0; t16 < 4; ++t16)
#pragma unroll
                    for (int r = 0; r < 4; ++r) { const int kl = 16 * t16 + 4 * q4 + r; float v = s[t16][r] * c1 - sl2 * (float)(dq - kl);
                        if (diag && kl > qloc) v = -1e30f; s[t16][r] = v; mx = fmaxf(mx, v); }
                mx = fmaxf(mx, __shfl_xor(mx, 16)); mx = fmaxf(mx, __shfl_xor(mx, 32));
                const float mn = fmaxf(m_run, mx), alpha = __builtin_amdgcn_exp2f(m_run - mn); m_run = mn;
                float ps = 0.f;
#pragma unroll
                for (int t16 = 0; t16 < 4; ++t16)
#pragma unroll
                    for (int r = 0; r < 4; ++r) { const float pv = __builtin_amdgcn_exp2f(s[t16][r] - mn); s[t16][r] = pv; ps += pv; }
                l_part = l_part * alpha + ps;
#pragma unroll
                for (int mt = 0; mt < 16; ++mt) O[mt] = O[mt] * alpha;
                bf16x8 pf[2];
#pragma unroll
                for (int ks = 0; ks < 2; ++ks) { v4u pw; pw.x = pk2(s[2 * ks][0], s[2 * ks][1]); pw.y = pk2(s[2 * ks][2], s[2 * ks][3]); pw.z = pk2(s[2 * ks + 1][0], s[2 * ks + 1][1]); pw.w = pk2(s[2 * ks + 1][2], s[2 * ks + 1][3]);
                    pf[ks] = __builtin_bit_cast(bf16x8, pw); }
#pragma unroll
                for (int mt = 0; mt < 16; ++mt)
#pragma unroll
                    for (int ks = 0; ks < 2; ++ks) { const LAS unsigned char* vp = VT + (16 * mt + l15) * 144 + (32 * ks + 4 * q4) * 2;
                        const v2u a0 = *(const LAS v2u*)vp, a1 = *(const LAS v2u*)(vp + 32);
                        v4u aw; aw.x = a0.x; aw.y = a0.y; aw.z = a1.x; aw.w = a1.y;
                        O[mt] = mfma16(__builtin_bit_cast(bf16x8, aw), pf[ks], O[mt]); }
            }
#undef ATT_LOAD
            float lt = l_part; lt += __shfl_xor(lt, 16); lt += __shfl_xor(lt, 32); const float inv = 1.0f / lt;
            __syncthreads();
            if (mi == 1) {
#pragma unroll
                for (int mt = 0; mt < 16; ++mt) *(LAS f32x4*)(XCH + ((wq * 16 + mt) * 64 + lane) * 16) = O[mt] * inv;
            }
            __syncthreads();
            if (mi == 0) {
                float ss = 0.f;
#pragma unroll
                for (int mt = 0; mt < 16; ++mt) { const f32x4 o1 = *(const LAS f32x4*)(XCH + ((wq * 16 + mt) * 64 + lane) * 16); const f32x4 o = O[mt] * inv - lam * o1; O[mt] = o;
                    ss += (o.x * o.x + o.y * o.y) + (o.z * o.z + o.w * o.w); }
                ss += __shfl_xor(ss, 16); ss += __shfl_xor(ss, 32);
                const float rs = (1.0f / sqrtf(ss * (1.0f / 256.0f) + LN_EPS)) * (1.0f - lambda_init);
                bf16* orow = MIX + (size_t)(b * SEQ + 64 * qb + qloc) * DM + 1024 + h * 256 + 4 * q4;
#pragma unroll
                for (int mt = 0; mt < 16; ++mt) { const f32x4 g = *(const f32x4*)(norm_g + 16 * mt + 4 * q4); const f32x4 o = O[mt] * rs * g;
                    v2u wv; wv.x = pk2(o.x, o.y); wv.y = pk2(o.z, o.w); *(v2u*)(orow + 16 * mt) = wv; }
            }
            __syncthreads();
        }
    }
}

__device__ __forceinline__ float softplus_f(float x) { return x > 20.0f ? x : log1pf(expf(x)); }
__device__ __forceinline__ void dn_prep_phase(LAS unsigned char* lds, const bf16* PROJ, const float* conv_w  , const float* a_log, const float* dt_bias,
                                              bf16* CHU, bf16* CHW, bf16* CHQD, bf16* CHKT, bf16* CHA, float* CHGL, int G) {
    int tid_ = threadIdx.x; asm volatile("" : "+v"(tid_)); const int tid = tid_, lane = tid & 63, w = __builtin_amdgcn_readfirstlane(tid >> 6), q4 = lane >> 4, l15 = lane & 15;
    LAS unsigned char* Q16 = lds; LAS unsigned char* K16 = lds + 17408;
    LAS float* VF = (LAS float*)(lds + 34816); LAS float* WF = (LAS float*)(lds + 68608);
    LAS float* LF = (LAS float*)(lds + 102400);
    LAS float* RQ = (LAS float*)(lds + 119808); LAS float* RK = RQ + 64; LAS float* BETA = RQ + 128; LAS float* GC = RQ + 192;
    for (int u = blockIdx.x; u < 1024; u += G) {
        const int b = u >> 8, h = (u >> 5) & 7, n = u & 31, m0 = b * SEQ + 64 * n, t0 = 64 * n;
#pragma unroll
        for (int sel = 0; sel < 3; ++sel) {
            const int col = sel * 1024 + h * 128 + 2 * lane;
            float cw0[4], cw1[4];
#pragma unroll
            for (int kk = 0; kk < 4; ++kk) { const f32x2 c2 = *(const f32x2*)(conv_w + kk * 3072 + col); cw0[kk] = c2.x; cw1[kk] = c2.y; }
            unsigned xr[11];
#pragma unroll
            for (int r = 0; r < 11; ++r) { const int tl = 8 * w + r - 3; xr[r] = (t0 + tl >= 0) ? *(const unsigned*)(PROJ + (size_t)(m0 + tl) * PLD + col) : 0u; }
#pragma unroll
            for (int t = 0; t < 8; ++t) {
                float y0 = 0.f, y1 = 0.f;
#pragma unroll
                for (int kk = 0; kk < 4; ++kk) { y0 += cw0[kk] * lo_bf(xr[t + kk]); y1 += cw1[kk] * hi_bf(xr[t + kk]); }
                y0 = silu_f(y0); y1 = silu_f(y1);
                const int i = 8 * w + t;
                if (sel < 2) { const float ss = wave_sum(y0 * y0 + y1 * y1); const float r = 1.0f / sqrtf(ss + 1e-6f);
                    if (lane == 0) { if (sel == 0) RQ[i] = r * 0.08838834764831845f; else RK[i] = r; }
                    *(LAS unsigned*)((sel == 0 ? Q16 : K16) + i * 272 + lane * 4) = pk2(y0, y1); }
                else *(LAS f32x2*)(VF + i * 132 + 2 * lane) = (f32x2){y0, y1};
            }
        }
        if (w == 0) {
            const float bv = bf2f(PROJ[(size_t)(m0 + lane) * PLD + 5120 + h]), av = bf2f(PROJ[(size_t)(m0 + lane) * PLD + 5128 + h]);
            float g = -expf(a_log[h]) * softplus_f(av + dt_bias[h]);
#pragma unroll
            for (int o = 1; o < 64; o <<= 1) { const float tv = __shfl_up(g, o); if (lane >= o) g += tv; }
            BETA[lane] = sigmoid_f(bv); GC[lane] = g;
        }
        __syncthreads();
        {
            const int prod = w >> 2, mt = w & 3; const LAS unsigned char* Ab = prod ? Q16 : K16;
            bf16x8 af[4];
#pragma unroll
            for (int sk = 0; sk < 4; ++sk) af[sk] = *(const LAS bf16x8*)(Ab + (16 * mt + l15) * 272 + (32 * sk + 8 * q4) * 2);
#pragma unroll
            for (int nt = 0; nt < 4; ++nt) { f32x4 acc = (f32x4){0.f, 0.f, 0.f, 0.f};
#pragma unroll
                for (int sk = 0; sk < 4; ++sk) { const bf16x8 bb = *(const LAS bf16x8*)(K16 + (16 * nt + l15) * 272 + (32 * sk + 8 * q4) * 2); acc = mfma16(af[sk], bb, acc); }
                const int jn = 16 * nt + l15; const float rkj = RK[jn], gj = GC[jn];
#pragma unroll
                for (int r = 0; r < 4; ++r) { const int i = 16 * mt + 4 * q4 + r; const float dec = expf(fminf(GC[i] - gj, 0.0f));
                    if (prod == 0) LF[i * 68 + jn] = (jn < i) ? acc[r] * BETA[i] * RK[i] * rkj * dec : 0.0f;
                    else CHA[(size_t)u * 4096 + i * 64 + jn] = (bf16)f2bf((jn <= i) ? acc[r] * RQ[i] * rkj * dec : 0.0f); }
            }
        }
#pragma unroll 4
        for (int it = 0; it < 16; ++it) { const int e = tid + 512 * it, i = e >> 7, d = e & 127;
            const float kn = bf2f(*(const LAS unsigned short*)(K16 + i * 272 + d * 2)) * RK[i], qn = bf2f(*(const LAS unsigned short*)(Q16 + i * 272 + d * 2)) * RQ[i];
            const float eg = expf(GC[i]), be = BETA[i];
            CHQD[(size_t)u * 8192 + e] = (bf16)f2bf(qn * eg);
            WF[i * 132 + d] = kn * be * eg; VF[i * 132 + d] *= be; }
#pragma unroll 4
        for (int it = 0; it < 16; ++it) { const int e = tid + 512 * it, d = e >> 6, i = e & 63;
            const float kn = bf2f(*(const LAS unsigned short*)(K16 + i * 272 + d * 2)) * RK[i];
            CHKT[(size_t)u * 8192 + e] = (bf16)f2bf(kn * expf(GC[63] - GC[i])); }
        __syncthreads();
        if (tid < 256) {
            const LAS float* X = (tid < 128) ? (VF + tid) : (WF + (tid - 128));
            const LAS float* LFo = LF; asm volatile("" : "+v"(LFo)); asm volatile("" : "+v"(X));
            float x[64];
#pragma unroll
            for (int i = 0; i < 64; ++i) {
                float acc = X[i * 132];
#pragma unroll
                for (int jb = 0; jb < (i + 3) / 4; ++jb) { const f32x4 l4 = *(const LAS f32x4*)(LFo + i * 68 + 4 * jb);
                    if (4 * jb + 0 < i) acc -= l4.x * x[4 * jb + 0];
                    if (4 * jb + 1 < i) acc -= l4.y * x[4 * jb + 1];
                    if (4 * jb + 2 < i) acc -= l4.z * x[4 * jb + 2];
                    if (4 * jb + 3 < i) acc -= l4.w * x[4 * jb + 3]; }
                x[i] = acc;
            }
            bf16* dst = (tid < 128) ? (CHU + (size_t)u * 8192 + tid) : (CHW + (size_t)u * 8192 + (tid - 128));
#pragma unroll
            for (int i = 0; i < 64; ++i) dst[i * 128] = (bf16)f2bf(x[i]);
            if (tid == 0) CHGL[u] = expf(GC[63]);
        }
        __syncthreads();
    }
}

__device__ __forceinline__ void dn_scan_phase(LAS unsigned char* lds, const bf16* CHU, const bf16* CHW, const bf16* CHQD, const bf16* CHKT, const bf16* CHA, const float* CHGL, float* ODN, int G) {
    int tid_ = threadIdx.x; asm volatile("" : "+v"(tid_)); const int tid = tid_, lane = tid & 63, w = __builtin_amdgcn_readfirstlane(tid >> 6), q4 = lane >> 4, l15 = lane & 15;
    LAS unsigned char* Wt = lds; LAS unsigned char* QDt = lds + 17408; LAS unsigned char* KTt = lds + 34816; LAS unsigned char* At = lds + 53248;
    LAS unsigned char* Ut = lds + 62464; LAS unsigned char* St = lds + 67584; LAS unsigned char* VNt = lds + 76288;
    const int mt = w >> 1, nt = w & 1;
    for (int u = blockIdx.x; u < 128; u += G) {
        const int bh = u >> 2, sl = u & 3, b = bh >> 3, h = bh & 7;
        __syncthreads();
        for (int e = tid; e < 8704 / 4; e += 512) ((LAS unsigned*)St)[e] = 0u;
        f32x4 Sr[2]; Sr[0] = (f32x4){0.f, 0.f, 0.f, 0.f}; Sr[1] = (f32x4){0.f, 0.f, 0.f, 0.f};
        v4u rw[2], rq[2], rk[2], ra, ru;
        ru = (v4u){0u, 0u, 0u, 0u};
#define DNS_LOAD(ch_) do { const size_t cb = (size_t)(ch_) * 8192; \
            _Pragma("unroll") for (int j = 0; j < 2; ++j) { const int c = tid + 512 * j; rw[j] = *(const v4u*)(CHW + cb + 8 * c); rq[j] = *(const v4u*)(CHQD + cb + 8 * c); rk[j] = *(const v4u*)(CHKT + cb + 8 * c); } \
            ra = *(const v4u*)(CHA + (size_t)(ch_) * 4096 + 8 * tid); \
            if (tid < 256) ru = *(const v4u*)(CHU + cb + (tid >> 2) * 128 + 32 * sl + (tid & 3) * 8); } while (0)
        DNS_LOAD(bh * 32);
        for (int n = 0; n < 32; ++n) {
            const int chunk = bh * 32 + n, m0 = b * SEQ + 64 * n;
#pragma unroll
            for (int j = 0; j < 2; ++j) { const int c = tid + 512 * j;
                *(LAS v4u*)(Wt + (c >> 4) * 272 + (c & 15) * 16) = rw[j]; *(LAS v4u*)(QDt + (c >> 4) * 272 + (c & 15) * 16) = rq[j];
                *(LAS v4u*)(KTt + (c >> 3) * 144 + (c & 7) * 16) = rk[j]; }
            *(LAS v4u*)(At + (tid >> 3) * 144 + (tid & 7) * 16) = ra;
            if (tid < 256) *(LAS v4u*)(Ut + (tid >> 2) * 80 + (tid & 3) * 16) = ru;
            __syncthreads();
            if (n < 31) DNS_LOAD(chunk + 1);
            const float gl = CHGL[chunk];
            {
                f32x4 acc = (f32x4){0.f, 0.f, 0.f, 0.f};
#pragma unroll
                for (int sk = 0; sk < 4; ++sk) { const bf16x8 a = *(const LAS bf16x8*)(Wt + (16 * mt + l15) * 272 + (32 * sk + 8 * q4) * 2);
                    const bf16x8 bb = *(const LAS bf16x8*)(St + (16 * nt + l15) * 272 + (32 * sk + 8 * q4) * 2); acc = mfma16(a, bb, acc); }
                float vn[4];
#pragma unroll
                for (int r = 0; r < 4; ++r) vn[r] = bf2f(*(const LAS unsigned short*)(Ut + (16 * mt + 4 * q4 + r) * 80 + (16 * nt + l15) * 2)) - acc[r];
                v2u pw; pw.x = pk2(vn[0], vn[1]); pw.y = pk2(vn[2], vn[3]);
                *(LAS v2u*)(VNt + (16 * nt + l15) * 144 + (16 * mt + 4 * q4) * 2) = pw;
            }
            __syncthreads();
            {
                f32x4 acc = (f32x4){0.f, 0.f, 0.f, 0.f};
#pragma unroll
                for (int sk = 0; sk < 4; ++sk) { const bf16x8 a = *(const LAS bf16x8*)(QDt + (16 * mt + l15) * 272 + (32 * sk + 8 * q4) * 2);
                    const bf16x8 bb = *(const LAS bf16x8*)(St + (16 * nt + l15) * 272 + (32 * sk + 8 * q4) * 2); acc = mfma16(a, bb, acc); }
#pragma unroll
                for (int sk = 0; sk < 2; ++sk) { const bf16x8 a = *(const LAS bf16x8*)(At + (16 * mt + l15) * 144 + (32 * sk + 8 * q4) * 2);
                    const bf16x8 bb = *(const LAS bf16x8*)(VNt + (16 * nt + l15) * 144 + (32 * sk + 8 * q4) * 2); acc = mfma16(a, bb, acc); }
                float* op = ODN + (size_t)(m0 + 16 * mt + 4 * q4) * 1024 + h * 128 + 32 * sl + 16 * nt + l15;
#pragma unroll
                for (int r = 0; r < 4; ++r) op[(size_t)r * 1024] = acc[r];
            }
#pragma unroll
            for (int dvt = 0; dvt < 2; ++dvt) { f32x4 acc = Sr[dvt] * gl;
#pragma unroll
                for (int sk = 0; sk < 2; ++sk) { const bf16x8 a = *(const LAS bf16x8*)(KTt + (16 * w + l15) * 144 + (32 * sk + 8 * q4) * 2);
                    const bf16x8 bb = *(const LAS bf16x8*)(VNt + (16 * dvt + l15) * 144 + (32 * sk + 8 * q4) * 2); acc = mfma16(a, bb, acc); }
                Sr[dvt] = acc; }
            __syncthreads();
#pragma unroll
            for (int dvt = 0; dvt < 2; ++dvt) { v2u pw; pw.x = pk2(Sr[dvt][0], Sr[dvt][1]); pw.y = pk2(Sr[dvt][2], Sr[dvt][3]);
                *(LAS v2u*)(St + (16 * dvt + l15) * 272 + (16 * w + 4 * q4) * 2) = pw; }
        }
#undef DNS_LOAD
    }
}
__device__ __forceinline__ void dn_gate_phase(const float* ODN, const bf16* PROJ, const float* norm_g, bf16* MIX, int G) {
    int tid_ = threadIdx.x; asm volatile("" : "+v"(tid_)); const int lane = tid_ & 63, gw = blockIdx.x * 8 + (tid_ >> 6), NGW = G * 8;
    const f32x2 g2 = *(const f32x2*)(norm_g + 2 * lane);
    for (int it = gw; it < MTOK * 8; it += NGW) { const int m = it >> 3, h = it & 7;
        const f32x2 o = *(const f32x2*)(ODN + (size_t)m * 1024 + h * 128 + 2 * lane);
        const float ss = wave_sum(o.x * o.x + o.y * o.y), r = 1.0f / sqrtf(ss * (1.0f / 128.0f) + LN_EPS);
        const unsigned zz = *(const unsigned*)(PROJ + (size_t)m * PLD + 3072 + h * 128 + 2 * lane);
        *(unsigned*)(MIX + (size_t)m * DM + h * 128 + 2 * lane) = pk2(o.x * r * g2.x * silu_f(lo_bf(zz)), o.y * r * g2.y * silu_f(hi_bf(zz))); }
}

__device__ __forceinline__ void sincos_cw(float x, float& s, float& c) {
    const float kf = rintf(x * 0.6366197723675814f); const int k = (int)kf;
    float r = fmaf(kf, -1.5703125f, x); r = fmaf(kf, -4.837512969970703125e-4f, r); r = fmaf(kf, -7.54978995489188216e-8f, r);
    const float r2 = r * r;
    const float sp = r + r * r2 * (-1.6666654611e-1f + r2 * (8.3321608736e-3f + r2 * (-1.9515295891e-4f)));
    const float cp = 1.0f - 0.5f * r2 + r2 * r2 * (4.166664568298827e-2f + r2 * (-1.388731625493765e-3f + r2 * 2.443315711809948e-5f));
    const int qd = k & 3;
    s = (qd == 0) ? sp : (qd == 1) ? cp : (qd == 2) ? -sp : -cp;
    c = (qd == 0) ? cp : (qd == 1) ? -sp : (qd == 2) ? -cp : sp;
}
struct S5Par { float abr, abi; float bbr[16], bbi[16]; };
__device__ __forceinline__ void s5_params(S5Par& P, const float* a_re, const float* a_im, const float* b_re, const float* b_im, const float* log_dt, int g, int lane) {
    const float are = a_re[g * 64 + lane], aim = a_im[g * 64 + lane], dt = expf(log_dt[g]);
    const float er = expf(are * dt); float sn, cs; sincos_cw(aim * dt, sn, cs);
    P.abr = er * cs; P.abi = er * sn;
    const float nr = P.abr - 1.0f, ni = P.abi, den = 1.0f / (are * are + aim * aim);
    const float cr = (nr * are + ni * aim) * den, ci = (ni * are - nr * aim) * den;
    const float* br = b_re + (size_t)(g * 64 + lane) * 16; const float* bi = b_im + (size_t)(g * 64 + lane) * 16;
#pragma unroll
    for (int c4 = 0; c4 < 4; ++c4) { const f32x4 r4 = *(const f32x4*)(br + 4 * c4), i4 = *(const f32x4*)(bi + 4 * c4);
#pragma unroll
        for (int j = 0; j < 4; ++j) { P.bbr[4 * c4 + j] = cr * r4[j] - ci * i4[j]; P.bbi[4 * c4 + j] = cr * i4[j] + ci * r4[j]; } }
}
#define S5_STEP(ubp_) do { const v4u ua = *(const LAS v4u*)(ubp_), ub2 = *(const LAS v4u*)((ubp_) + 16); float uu[16]; \
        uu[0] = lo_bf(ua.x); uu[1] = hi_bf(ua.x); uu[2] = lo_bf(ua.y); uu[3] = hi_bf(ua.y); uu[4] = lo_bf(ua.z); uu[5] = hi_bf(ua.z); uu[6] = lo_bf(ua.w); uu[7] = hi_bf(ua.w); \
        uu[8] = lo_bf(ub2.x); uu[9] = hi_bf(ub2.x); uu[10] = lo_bf(ub2.y); uu[11] = hi_bf(ub2.y); uu[12] = lo_bf(ub2.z); uu[13] = hi_bf(ub2.z); uu[14] = lo_bf(ub2.w); uu[15] = hi_bf(ub2.w); \
        float br_ = 0.f, bi_ = 0.f; _Pragma("unroll") for (int c = 0; c < 16; ++c) { br_ += P.bbr[c] * uu[c]; bi_ += P.bbi[c] * uu[c]; } \
        const float nr_ = P.abr * sr - P.abi * si + br_, ni_ = P.abr * si + P.abi * sr + bi_; sr = nr_; si = ni_; } while (0)
__device__ __forceinline__ void s5_pass1(LAS unsigned char* lds, const bf16* PROJ, const float* a_re, const float* a_im, const float* b_re, const float* b_im, const float* log_dt,
                                         float* S5END, int first, int nblk) {
    int tid_ = threadIdx.x; asm volatile("" : "+v"(tid_)); const int tid = tid_, lane = tid & 63, w = __builtin_amdgcn_readfirstlane(tid >> 6);
    LAS unsigned char* ub = lds + w * 2048;
    for (int bi = (int)blockIdx.x - first; bi < 256; bi += nblk) {
        const int b = bi >> 6, g = bi & 63;
        S5Par P; s5_params(P, a_re, a_im, b_re, b_im, log_dt, g, lane);
        float sr = 0.f, si = 0.f;
        for (int sb = 0; sb < 4; ++sb) {
            const bf16* up = PROJ + (size_t)(b * SEQ + w * 256 + sb * 64 + lane) * PLD + 4096 + 16 * g;
            const v4u u0 = *(const v4u*)up, u1 = *(const v4u*)(up + 8);
            LDS_WAIT();
            *(LAS v4u*)(ub + lane * 32) = u0; *(LAS v4u*)(ub + lane * 32 + 16) = u1;
            LDS_WAIT();
            for (int tt = 0; tt < 64; ++tt) { S5_STEP(ub + tt * 32); }
        }
        *(f32x2*)(S5END + ((size_t)(bi * 8 + w) * 64 + lane) * 2) = (f32x2){sr, si};
    }
}
__device__ __forceinline__ float gelu_tanh_f(float y) { const float a = 0.7978845608028654f * (y + 0.044715f * y * y * y); const float t = 1.0f - 2.0f / (__expf(2.0f * a) + 1.0f); return 0.5f * y * (1.0f + t); }
__device__ __forceinline__ void s5_pass2(LAS unsigned char* lds, const bf16* PROJ, const float* a_re, const float* a_im, const float* b_re, const float* b_im, const float* c_re, const float* c_im,
                                         const float* dvec, const float* log_dt, const float* S5END, bf16* YPRE, int first, int nblk) {
    int tid_ = threadIdx.x; asm volatile("" : "+v"(tid_)); const int tid = tid_, lane = tid & 63, w = __builtin_amdgcn_readfirstlane(tid >> 6);
    LAS float* CL = (LAS float*)lds;
    LAS unsigned char* ub = lds + 8192 + w * 2048;
    LAS f32x2* SB = (LAS f32x2*)(lds + 24576 + w * 8320);
    for (int bi = (int)blockIdx.x - first; bi < 256; bi += nblk) {
        const int b = bi >> 6, g = bi & 63;
        __syncthreads();
        for (int e = tid; e < 1024; e += 512) { const int p = e >> 4, c = e & 15; CL[e * 2] = c_re[(size_t)(g * 16 + c) * 64 + p]; CL[e * 2 + 1] = c_im[(size_t)(g * 16 + c) * 64 + p]; }
        __syncthreads();
        S5Par P; s5_params(P, a_re, a_im, b_re, b_im, log_dt, g, lane);
        float sr = 0.f, si = 0.f;
        { float pr = P.abr, pi = P.abi;
#pragma unroll
          for (int k = 0; k < 8; ++k) { const float t = pr * pr - pi * pi; pi = 2.0f * pr * pi; pr = t; }
          for (int i = 0; i < w; ++i) { const f32x2 e = *(const f32x2*)(S5END + ((size_t)(bi * 8 + i) * 64 + lane) * 2);
              const float nr = sr * pr - si * pi + e.x, ni = sr * pi + si * pr + e.y; sr = nr; si = ni; } }
        const int tq = lane >> 2, cg = lane & 3;
        const f32x4 d4 = *(const f32x4*)(dvec + g * 16 + 4 * cg);
        for (int sb = 0; sb < 4; ++sb) {
            const int trow = b * SEQ + w * 256 + sb * 64;
            { const bf16* up = PROJ + (size_t)(trow + lane) * PLD + 4096 + 16 * g; const v4u u0 = *(const v4u*)up, u1 = *(const v4u*)(up + 8);
              LDS_WAIT(); *(LAS v4u*)(ub + lane * 32) = u0; *(LAS v4u*)(ub + lane * 32 + 16) = u1; LDS_WAIT(); }
            for (int blk = 0; blk < 4; ++blk) {
#pragma unroll 4
                for (int tt = 0; tt < 16; ++tt) { S5_STEP(ub + (blk * 16 + tt) * 32); SB[tt * 65 + lane] = (f32x2){sr, si}; }
                LDS_WAIT();
                float y0 = 0.f, y1 = 0.f, y2 = 0.f, y3 = 0.f;
#pragma unroll 8
                for (int p = 0; p < 64; ++p) { const f32x2 s = SB[tq * 65 + p]; const f32x4 c0 = *(const LAS f32x4*)(CL + p * 32 + 8 * cg), c1 = *(const LAS f32x4*)(CL + p * 32 + 8 * cg + 4);
                    y0 += c0.x * s.x - c0.y * s.y; y1 += c0.z * s.x - c0.w * s.y; y2 += c1.x * s.x - c1.y * s.y; y3 += c1.z * s.x - c1.w * s.y; }
                const v2u uw = *(const LAS v2u*)(ub + (blk * 16 + tq) * 32 + 8 * cg);
                y0 += d4.x * lo_bf(uw.x); y1 += d4.y * hi_bf(uw.x); y2 += d4.z * lo_bf(uw.y); y3 += d4.w * hi_bf(uw.y);
                v2u o; o.x = pk2(gelu_tanh_f(y0), gelu_tanh_f(y1)); o.y = pk2(gelu_tanh_f(y2), gelu_tanh_f(y3));
                *(v2u*)(YPRE + (size_t)(trow + blk * 16 + tq) * 1024 + 16 * g + 4 * cg) = o;
                LDS_WAIT();
            }
        }
    }
}

#ifndef PH_MASK
#define PH_MASK 0xffffffffu
#endif
#define EN(k) (((PH_MASK) >> (k)) & 1u)
__global__ void __launch_bounds__(512, 2) fwd(Args args) {
    extern __shared__ __attribute__((aligned(16))) unsigned char lds_raw[];
    LAS unsigned char* lds = (LAS unsigned char*)lds_raw;
    const int tid = threadIdx.x, G = gridDim.x;
    unsigned char* ws = args.ws;
    const int lo = args.ph_lo, hi = args.ph_hi;
    volatile LAS unsigned* MISC = (volatile LAS unsigned*)(lds + LDS_MISC);
    if (tid < 8) MISC[tid] = 0u;
    __syncthreads();
    XcdBarrier bar; bar.bar = (unsigned*)(ws + WS_CTL) + CW_BAR; bar.x = 0; bar.st = nullptr;
    if (hi - lo > 1) bar = xcd_barrier_post((unsigned*)(ws + WS_CTL) + CW_BAR, MISC);
#define IN(k) (lo <= (k) && (k) < hi)
#define SEAM(k) do { if ((k) + 1 < hi) xcd_barrier(bar); } while (0)
    float* X = (float*)(ws + WS_X); bf16* H = (bf16*)(ws + WS_H); bf16* PROJ = (bf16*)(ws + WS_PROJ); bf16* MIX = (bf16*)(ws + WS_MIX);
    float* Y = (float*)(ws + WS_Y); bf16* HID = (bf16*)(ws + WS_HID); float* MOD = (float*)(ws + WS_MOD); bf16* YPRE = (bf16*)(ws + WS_YPRE); float* ODN = (float*)(ws + WS_ODN);
    bf16* CHU = (bf16*)(ws + WS_CHU); bf16* CHW = (bf16*)(ws + WS_CHW); bf16* CHQD = (bf16*)(ws + WS_CHQD); bf16* CHKT = (bf16*)(ws + WS_CHKT); bf16* CHA = (bf16*)(ws + WS_CHA);
    float* CHGL = (float*)(ws + WS_CHGL); float* S5END = (float*)(ws + WS_S5END);

    if (IN(0)) { if (EN(0)) p0a_phase(lds, args, G); SEAM(0); }
    if (IN(1)) { if (EN(1)) modulate_phase(args.in[0], MOD, 0, 2048, H, G); SEAM(1); }

#pragma nounroll
    for (int i = 0; i < 4; ++i) {
        const int j = i >> 1; const bool odd = (i & 1) != 0;
        int p = 2 + j * 16 + (odd ? 9 : 0);
        const float* MODl = MOD + (size_t)i * 4 * 12288;
        const float* Xin = (i == 0) ? args.in[0] : X;
        if (IN(p)) {
            pg8::Gemm g{H, (const bf16*)(ws + WS_WIN + i * WIN_STRIDE), MTOK, odd ? NIN_O : NIN_E, DM}; pg8::StaticOrder S; S.init(MTOK, g.N, G, (int)blockIdx.x);
            pg8::EpiB16 E{PROJ, PLD};
            if (EN(2)) pg8::gemm_phase<pg8::EpiB16, pg8::StaticOrder, true, true>(lds, g, S, E);
            SEAM(p);
        }
        ++p;
        if (!odd) {
            const float* a_re = args.in[17] + (size_t)j * 4096; const float* a_im = args.in[18] + (size_t)j * 4096;
            const float* b_re = args.in[19] + (size_t)j * 65536; const float* b_im = args.in[20] + (size_t)j * 65536;
            const float* c_re = args.in[21] + (size_t)j * 65536; const float* c_im = args.in[22] + (size_t)j * 65536;
            const float* s5d = args.in[23] + (size_t)j * 1024; const float* log_dt = args.in[24] + (size_t)j * 64;
            if (IN(p)) {
                if (EN(3)) dn_prep_phase(lds, PROJ, args.in[13] + (size_t)j * 4 * 3072, args.in[14] + j * 8, args.in[15] + j * 8, CHU, CHW, CHQD, CHKT, CHA, CHGL, G);
                if (EN(4)) s5_pass1(lds, PROJ, a_re, a_im, b_re, b_im, log_dt, S5END, 0, G);
                SEAM(p);
            }
            ++p;
            if (IN(p)) {
                const int first = (G >= 256) ? 128 : 0;
                if (EN(5)) if ((int)blockIdx.x < 128 || first == 0) dn_scan_phase(lds, CHU, CHW, CHQD, CHKT, CHA, CHGL, ODN, (first == 0) ? G : 128);
                if (EN(6)) if ((int)blockIdx.x >= first) s5_pass2(lds, PROJ, a_re, a_im, b_re, b_im, c_re, c_im, s5d, log_dt, S5END, YPRE, first, G - first);
                SEAM(p);
            }
            ++p;
            if (IN(p)) {
                pg8::Gemm g{YPRE, (const bf16*)(ws + WS_WGLU + j * WGLU_STRIDE), MTOK, 1024, 1024}; pg8::StaticOrder S; S.init(MTOK, 1024, G, (int)blockIdx.x);
                pg8::EpiGlu E{YPRE, 1024, MIX, DM, 1024};
                if (EN(7)) pg8::gemm_phase<pg8::EpiGlu, pg8::StaticOrder, true, true>(lds, g, S, E);
                if (EN(8)) dn_gate_phase(ODN, PROJ, args.in[16] + j * 128, MIX, G);
                SEAM(p);
            }
            ++p;
        } else {
            if (IN(p)) {
                if (EN(9)) shortconv_phase(PROJ, args.in[28] + (size_t)j * 3 * 1024, MIX, G);
                const float lambda_init = (i == 1) ? 0.35550906759277307f : 0.55605818415556050f;
                if (EN(10)) attn_phase(lds, PROJ, MIX, args.in[29] + j * 128, args.in[30] + j * 128, args.in[31] + j * 128, args.in[32] + j * 128, args.in[33] + j * 256, lambda_init, G);
                SEAM(p);
            }
            ++p;
        }
        if (IN(p)) {
            pg8::Gemm g{MIX, (const bf16*)(ws + WS_WOUT + i * WOUT_STRIDE), MTOK, DM, DM}; pg8::StaticOrder S; S.init(MTOK, DM, G, (int)blockIdx.x);
            pg8::EpiF32o E{Y, DM};
            if (EN(11)) pg8::gemm_phase<pg8::EpiF32o, pg8::StaticOrder, true, true>(lds, g, S, E);
            SEAM(p);
        }
        ++p;
        if (IN(p)) { if (EN(12)) ln_phase(Xin, Y, X, H, MODl + 4096, args.in[4] + i * DM, args.in[5] + i * DM, MODl, 6144, 8192, G); SEAM(p); }
        ++p;
        if (IN(p)) {
            pg8::Gemm g{H, (const bf16*)(ws + WS_WGU + i * WGU_STRIDE), MTOK, 2 * DFF, DM}; pg8::StaticOrder S; S.init(MTOK, 2 * DFF, G, (int)blockIdx.x);
            pg8::EpiSwiGlu E{HID, DFF};
            if (EN(13)) pg8::gemm_phase<pg8::EpiSwiGlu, pg8::StaticOrder, true, true>(lds, g, S, E);
            SEAM(p);
        }
        ++p;
        if (IN(p)) {
            pg8::Gemm g{HID, (const bf16*)(ws + WS_WDN + i * WDN_STRIDE), MTOK, DM, DFF}; pg8::StaticOrder S; S.init(MTOK, DM, G, (int)blockIdx.x);
            pg8::EpiF32o E{Y, DM};
            if (EN(14)) pg8::gemm_phase<pg8::EpiF32o, pg8::StaticOrder, true, true>(lds, g, S, E);
            SEAM(p);
        }
        ++p;
        if (IN(p)) {
            if (EN(15)) { if (i < 3) ln_phase(X, Y, X, H, MODl + 10240, args.in[6] + i * DM, args.in[7] + i * DM, MODl + 4 * 12288, 0, 2048, G);
            else ln_phase(X, Y, args.out, H, MODl + 10240, args.in[6] + i * DM, args.in[7] + i * DM, nullptr, 0, 0, G); }
            SEAM(p);
        }
        ++p;
    }
#undef IN
#undef SEAM
}

extern "C" void kernel_launch(void* const* d_in, const int* in_sizes, int n_in, void* d_out, int out_size, void* d_ws, size_t ws_size, hipStream_t stream) {
    static int grid = 0;
    if (grid == 0) {
        if (n_in != 34 || in_sizes[0] != MTOK * DM || out_size != MTOK * DM || ws_size < WS_END) {
            fprintf(stderr, "kernel_launch: unexpected shapes (n_in %d, in0 %d, out %d, ws %zu < %zu); nothing launched\n", n_in, n_in > 0 ? in_sizes[0] : -1, out_size, ws_size, (size_t)WS_END); grid = -1; return; }
        int dev = 0, cus = 0;
        if (hipGetDevice(&dev) != hipSuccess || hipDeviceGetAttribute(&cus, hipDeviceAttributeMultiprocessorCount, dev) != hipSuccess) { fprintf(stderr, "kernel_launch: device query failed\n"); grid = -1; return; }
        if (hipFuncSetAttribute((const void*)fwd, hipFuncAttributeMaxDynamicSharedMemorySize, LDS_BYTES) != hipSuccess) { fprintf(stderr, "kernel_launch: hipFuncSetAttribute failed\n"); grid = -1; return; }
        int per_cu = 0;
        if (hipOccupancyMaxActiveBlocksPerMultiprocessor(&per_cu, (const void*)fwd, 512, LDS_BYTES) != hipSuccess || per_cu < 1) fprintf(stderr, "kernel_launch: note: occupancy query reports %d\n", per_cu);
        (void)hipGetLastError();
        grid = cus;
    }
    if (grid < 0) return;
    if (hipMemsetAsync((char*)d_ws + WS_CTL, 0, CTL_ZERO_BYTES, stream) != hipSuccess) { fprintf(stderr, "kernel_launch: memset failed\n"); return; }
    Args a{};
    for (int i = 0; i < 34; ++i) a.in[i] = (const float*)d_in[i];
    a.out = (float*)d_out; a.ws = (unsigned char*)d_ws;
#if MK_MULTI
    for (int p = 0; p < NPH; ++p) { a.ph_lo = p; a.ph_hi = p + 1; hipLaunchKernelGGL(fwd, dim3(grid), dim3(512), LDS_BYTES, stream, a); }
#else
    a.ph_lo = 0; a.ph_hi = NPH; hipLaunchKernelGGL(fwd, dim3(grid), dim3(512), LDS_BYTES, stream, a);
#endif
    const hipError_t le = hipPeekAtLastError();
    if (le != hipSuccess) fprintf(stderr, "kernel_launch: launch failed: %s\n", hipGetErrorName(le));
}
```

```cpp
#include <hip/hip_runtime.h>
#include <cstdio>
#include <cstdint>
#ifndef MK_MULTI
#define MK_MULTI 0
#endif
namespace pg8 {
#define PG8_LAS __attribute__((address_space(3)))
typedef unsigned short bf16_t;
typedef short bf16x8 __attribute__((ext_vector_type(8)));
typedef float f32x4 __attribute__((ext_vector_type(4)));
typedef unsigned u32x4 __attribute__((ext_vector_type(4)));
constexpr int BM = 256, BK = 64, HALF = 128, HTB = HALF * BK * 2  , STAGE_BYTES = 8 * HTB, NXCD = 8, WGM = 8;

__host__ __device__ __forceinline__ int lds_byte(int r, int c) { const int st = (r >> 4) * 2 + (c >> 5), rr = r & 15, cc = c & 31, ob = rr * 64 + cc * 2; return st * 1024 + (ob ^ (((ob >> 9) & 1) << 5)); }
__host__ __device__ __forceinline__ void stage_rc(int b, int& R, int& C) { const int st = b / 1024, sb = b % 1024, swz = sb ^ (((sb >> 9) & 1) << 5); R = (st >> 1) * 16 + swz / 64; C = (st & 1) * 32 + (swz % 64) / 2; }
__host__ __device__ __forceinline__ int perm32(int rho) { const int n = rho >> 4, i = rho & 15; return 8 * (i >> 2) + 4 * n + (i & 3); }

struct Unit { int pm, pn; };
struct Gemm { const bf16_t* A; const bf16_t* Bt; int M, N, K; };

struct StaticOrder {
    int nM, nN, nwg, G, c;
    __host__ __device__ void init(int M, int N, int G_, int c_) { nM = M / BM; nN = N / BM; nwg = nM * nN; G = G_; c = c_; }
    __host__ __device__ bool next(int i, Unit& u) const {
        const long L = (long)i * G + c; if (L >= nwg) return false;
        int wgid = (int)L; { const int q = nwg / NXCD, r = nwg % NXCD, xcd = wgid % NXCD, off = wgid / NXCD; wgid = (xcd < r ? xcd * (q + 1) : r * (q + 1) + (xcd - r) * q) + off; }
        const int nig = WGM * nN, gid = wgid / nig, fm = gid * WGM, gsz = (nM - fm) < WGM ? (nM - fm) : WGM;
        u.pm = fm + ((wgid % nig) % gsz); u.pn = (wgid % nig) / gsz; return true;
    }
    __device__ __forceinline__ void a_ready(const Unit&) const {}
    __device__ __forceinline__ void done(const Unit&) const {}
};

__device__ __forceinline__ unsigned cvt_pk_bf16(float lo, float hi) { unsigned r; asm volatile("v_cvt_pk_bf16_f32 %0, %1, %2" : "=v"(r) : "v"(lo), "v"(hi)); return r; }
__device__ __forceinline__ float ep_sigmoid(float x) { return __builtin_amdgcn_rcpf(1.0f + __expf(-x)); }
__device__ __forceinline__ float ep_lo(unsigned w) { return __uint_as_float(w << 16); }
__device__ __forceinline__ float ep_hi(unsigned w) { return __uint_as_float(w & 0xffff0000u); }
struct EpiB16 {
    static constexpr bool PERM = true, AFTER_DRAIN = false;
    bf16_t* O; int ldc;
    __device__ __forceinline__ void operator()(const f32x4 (&acc)[2][2][4][2], const Unit& u, int wr, int wc, int fr, int fq) const {
        const int row0 = u.pm * BM + wr * 64 + fr, col0 = u.pn * BM + wc * 32 + 8 * fq;
#pragma unroll
        for (int ai = 0; ai < 2; ++ai)
#pragma unroll
            for (int m = 0; m < 4; ++m) { bf16_t* rowp = O + (size_t)(row0 + ai * HALF + m * 16) * ldc + col0;
#pragma unroll
                for (int bj = 0; bj < 2; ++bj) { const f32x4 v0 = acc[ai][bj][m][0], v1 = acc[ai][bj][m][1];
                    u32x4 w; w.x = cvt_pk_bf16(v0[0], v0[1]); w.y = cvt_pk_bf16(v0[2], v0[3]); w.z = cvt_pk_bf16(v1[0], v1[1]); w.w = cvt_pk_bf16(v1[2], v1[3]);
                    *(u32x4*)(rowp + bj * HALF) = w; } }
    }
};
struct EpiF32o {
    static constexpr bool PERM = false, AFTER_DRAIN = false;
    float* C; int ldc;
    __device__ __forceinline__ void operator()(const f32x4 (&acc)[2][2][4][2], const Unit& u, int wr, int wc, int fr, int fq) const {
        const int row0 = u.pm * BM + wr * 64 + fr, col0 = u.pn * BM + wc * 32 + 4 * fq;
#pragma unroll
        for (int ai = 0; ai < 2; ++ai)
#pragma unroll
            for (int m = 0; m < 4; ++m) { float* rowp = C + (size_t)(row0 + ai * HALF + m * 16) * ldc + col0;
#pragma unroll
                for (int bj = 0; bj < 2; ++bj)
#pragma unroll
                    for (int n = 0; n < 2; ++n) *(f32x4*)(rowp + bj * HALF + n * 16) = acc[ai][bj][m][n]; }
    }
};
struct EpiSwiGlu {
    static constexpr bool PERM = true, AFTER_DRAIN = false;
    bf16_t* O; int ldc;
    __device__ __forceinline__ void operator()(const f32x4 (&acc)[2][2][4][2], const Unit& u, int wr, int wc, int fr, int fq) const {
        const int row0 = u.pm * BM + wr * 64 + fr, col0 = u.pn * HALF + wc * 32 + 8 * fq;
#pragma unroll
        for (int ai = 0; ai < 2; ++ai)
#pragma unroll
            for (int m = 0; m < 4; ++m) { bf16_t* rowp = O + (size_t)(row0 + ai * HALF + m * 16) * ldc + col0;
                float h[8];
#pragma unroll
                for (int n = 0; n < 2; ++n)
#pragma unroll
                    for (int j = 0; j < 4; ++j) { const float g = acc[ai][0][m][n][j], up = acc[ai][1][m][n][j]; h[4 * n + j] = g * ep_sigmoid(g) * up; }
                u32x4 w; w.x = cvt_pk_bf16(h[0], h[1]); w.y = cvt_pk_bf16(h[2], h[3]); w.z = cvt_pk_bf16(h[4], h[5]); w.w = cvt_pk_bf16(h[6], h[7]);
                *(u32x4*)rowp = w; }
    }
};
struct EpiGlu {
    static constexpr bool PERM = true, AFTER_DRAIN = false;
    const bf16_t* Y; int ldy; bf16_t* O; int ldo; int ocol0;
    __device__ __forceinline__ void operator()(const f32x4 (&acc)[2][2][4][2], const Unit& u, int wr, int wc, int fr, int fq) const {
        const int row0 = u.pm * BM + wr * 64 + fr, col0 = u.pn * BM + wc * 32 + 8 * fq;
#pragma unroll
        for (int ai = 0; ai < 2; ++ai)
#pragma unroll
            for (int m = 0; m < 4; ++m) { const size_t row = (size_t)(row0 + ai * HALF + m * 16);
#pragma unroll
                for (int bj = 0; bj < 2; ++bj) { const f32x4 v0 = acc[ai][bj][m][0], v1 = acc[ai][bj][m][1];
                    const u32x4 yv = *(const u32x4*)(Y + row * ldy + col0 + bj * HALF);
                    u32x4 w;
                    w.x = cvt_pk_bf16(ep_lo(yv.x) * ep_sigmoid(v0[0]), ep_hi(yv.x) * ep_sigmoid(v0[1]));
                    w.y = cvt_pk_bf16(ep_lo(yv.y) * ep_sigmoid(v0[2]), ep_hi(yv.y) * ep_sigmoid(v0[3]));
                    w.z = cvt_pk_bf16(ep_lo(yv.z) * ep_sigmoid(v1[0]), ep_hi(yv.z) * ep_sigmoid(v1[1]));
                    w.w = cvt_pk_bf16(ep_lo(yv.w) * ep_sigmoid(v1[2]), ep_hi(yv.w) * ep_sigmoid(v1[3]));
                    *(u32x4*)(O + row * ldo + ocol0 + col0 + bj * HALF) = w; } }
    }
};

template <class Epi, class Sched, bool ALIGN_EPI = false, bool SP2 = false>
__device__ __forceinline__ void gemm_phase(PG8_LAS unsigned char* lds, const Gemm g, const Sched& S, const Epi& E) {
    int tid_ = threadIdx.x; asm volatile("" : "+v"(tid_));   const int tid = tid_, wid = __builtin_amdgcn_readfirstlane(tid >> 6), lane = tid & 63, wr = wid >> 2, wc = wid & 3, fr = lane & 15, fq = lane >> 4;
    const int K = g.K, nt = K / BK;
    unsigned voffA[2], voffB[2];
#pragma unroll
    for (int i = 0; i < 2; ++i) { int R, C; stage_rc(tid * 16 + i * 8192, R, C); const int Rb = Epi::PERM ? ((R & ~31) + perm32(R & 31)) : R;
        voffA[i] = (unsigned)(R * K + C) * 2u; voffB[i] = (unsigned)(Rb * K + C) * 2u; }
    const size_t kstep = (size_t)(BK * 2);
    const size_t hstep = (size_t)HALF * K * 2;
    const size_t tstep = 2 * hstep;
    const unsigned ldsw = (unsigned)wid * 1024u;
    const int aoff = lds_byte(wr * 64 + fr, fq * 8), boff = lds_byte(wc * 32 + fr, fq * 8);
#define PG8_SA(b, h) (((b) * 2 + (h)) * HTB)
#define PG8_SB(b, h) ((4 + (b) * 2 + (h)) * HTB)
#define PG8_STAGE(bufoff, gbase, voff) do { _Pragma("unroll") for (int _i = 0; _i < 2; ++_i) \
        __builtin_amdgcn_global_load_lds((const unsigned*)((const char*)(gbase) + (voff)[_i]), (PG8_LAS unsigned*)(lds + (bufoff) + ldsw + _i * 8192), 16, 0, 0); } while (0)
#define PG8_LDA(dst, b, h) do { _Pragma("unroll") for (int m = 0; m < 4; ++m) _Pragma("unroll") for (int k = 0; k < 2; ++k) dst[m][k] = *(const PG8_LAS bf16x8*)(lds + PG8_SA(b, h) + aoff + m * 2048 + k * 1024); } while (0)
#define PG8_LDB(dst, b, h) do { _Pragma("unroll") for (int n = 0; n < 2; ++n) _Pragma("unroll") for (int k = 0; k < 2; ++k) dst[n][k] = *(const PG8_LAS bf16x8*)(lds + PG8_SB(b, h) + boff + n * 2048 + k * 1024); } while (0)
#define PG8_MMA(ai, bj, At, Bt) do { __builtin_amdgcn_s_setprio(1); _Pragma("unroll") for (int m = 0; m < 4; ++m) _Pragma("unroll") for (int n = 0; n < 2; ++n) _Pragma("unroll") for (int k = 0; k < 2; ++k) \
        acc[ai][bj][m][n] = __builtin_amdgcn_mfma_f32_16x16x32_bf16(Bt[n][k], At[m][k], acc[ai][bj][m][n], 0, 0, 0); __builtin_amdgcn_s_setprio(0); } while (0)
#define PG8_WAIT_V(n) asm volatile("s_waitcnt vmcnt(" #n ")" ::: "memory")
#define PG8_WAIT_L(n) asm volatile("s_waitcnt lgkmcnt(" #n ")" ::: "memory")
#define PG8_BAR __builtin_amdgcn_s_barrier()
#define PG8_SCHED __builtin_amdgcn_sched_barrier(0)
    Unit cur, nxt; int ui = 0;
    if (!S.next(0, cur)) return;
    f32x4 acc[2][2][4][2];
#pragma unroll
    for (int a = 0; a < 2; ++a)
#pragma unroll
        for (int b = 0; b < 2; ++b)
#pragma unroll
            for (int m = 0; m < 4; ++m)
#pragma unroll
                for (int n = 0; n < 2; ++n) acc[a][b][m][n] = (f32x4){0.f, 0.f, 0.f, 0.f};
    bf16x8 At[4][2], B0[2][2], B1[2][2];
    const char* cA = (const char*)g.A + (size_t)cur.pm * tstep; const char* cB = (const char*)g.Bt + (size_t)cur.pn * tstep;
    S.a_ready(cur);
    if constexpr (SP2) {
        PG8_STAGE(PG8_SB(0, 0), cB, voffB); PG8_STAGE(PG8_SB(0, 1), cB + hstep, voffB); PG8_STAGE(PG8_SA(0, 0), cA, voffA); PG8_STAGE(PG8_SA(0, 1), cA + hstep, voffA);
        if (wr == 1) PG8_BAR;
        PG8_WAIT_V(2); PG8_BAR;
        PG8_STAGE(PG8_SB(1, 0), cB + kstep, voffB); PG8_STAGE(PG8_SA(1, 0), cA + kstep, voffA); PG8_STAGE(PG8_SB(1, 1), cB + hstep + kstep, voffB);
        PG8_WAIT_V(6); PG8_BAR;
    } else {
        PG8_STAGE(PG8_SB(0, 0), cB, voffB); PG8_STAGE(PG8_SA(0, 0), cA, voffA); PG8_STAGE(PG8_SB(0, 1), cB + hstep, voffB); PG8_STAGE(PG8_SA(0, 1), cA + hstep, voffA);
        if (wr == 1) PG8_BAR;
        PG8_WAIT_V(4); PG8_BAR;
        PG8_STAGE(PG8_SB(1, 0), cB + kstep, voffB); PG8_STAGE(PG8_SA(1, 0), cA + kstep, voffA); PG8_STAGE(PG8_SB(1, 1), cB + hstep + kstep, voffB);
        PG8_WAIT_V(6); PG8_BAR;
    }
    for (;;) {
        const bool has_next = S.next(ui + 1, nxt);
        const char* nA = has_next ? (const char*)g.A + (size_t)nxt.pm * tstep : cA; const char* nB = has_next ? (const char*)g.Bt + (size_t)nxt.pn * tstep : cB;
        for (int t = 0; t < nt; t += 2) {
            const bool last = (t == nt - 2);
            const char* a1 = cA + (size_t)(t + 1) * kstep;
            const char* a2 = last ? nA : cA + (size_t)(t + 2) * kstep; const char* b2 = last ? nB : cB + (size_t)(t + 2) * kstep;
            const char* a3 = a2 + kstep; const char* b3 = b2 + kstep;
            if (last && has_next) S.a_ready(nxt);
            if constexpr (SP2) {
            PG8_LDB(B0, 0, 0); PG8_LDB(B1, 0, 1); PG8_SCHED; PG8_LDA(At, 0, 0); PG8_STAGE(PG8_SA(1, 1), a1 + hstep, voffA);
            PG8_WAIT_V(8); PG8_WAIT_L(0); PG8_BAR; PG8_MMA(0, 0, At, B0); PG8_MMA(0, 1, At, B1); PG8_BAR; PG8_SCHED;
            PG8_LDA(At, 0, 1); PG8_STAGE(PG8_SB(0, 0), b2, voffB); PG8_STAGE(PG8_SB(0, 1), b2 + hstep, voffB); PG8_STAGE(PG8_SA(0, 0), a2, voffA);
            PG8_WAIT_V(8); PG8_WAIT_L(0); PG8_BAR; PG8_MMA(1, 0, At, B0); PG8_MMA(1, 1, At, B1); PG8_BAR; PG8_SCHED;
            PG8_LDB(B0, 1, 0); PG8_LDB(B1, 1, 1); PG8_SCHED; PG8_LDA(At, 1, 0); PG8_STAGE(PG8_SA(0, 1), a2 + hstep, voffA);
            PG8_WAIT_V(8); PG8_WAIT_L(0); PG8_BAR; PG8_MMA(0, 0, At, B0); PG8_MMA(0, 1, At, B1); PG8_BAR; PG8_SCHED;
            PG8_LDA(At, 1, 1); PG8_STAGE(PG8_SB(1, 0), b3, voffB); PG8_STAGE(PG8_SB(1, 1), b3 + hstep, voffB); PG8_STAGE(PG8_SA(1, 0), a3, voffA);
            PG8_WAIT_V(8); PG8_WAIT_L(0); PG8_BAR; PG8_MMA(1, 0, At, B0); PG8_MMA(1, 1, At, B1); PG8_BAR; PG8_SCHED;
            } else {
            PG8_LDB(B0, 0, 0); PG8_SCHED; PG8_LDA(At, 0, 0); PG8_STAGE(PG8_SA(1, 1), a1 + hstep, voffA);
            PG8_WAIT_L(8); PG8_BAR; PG8_WAIT_L(0); PG8_MMA(0, 0, At, B0); PG8_BAR; PG8_SCHED;
            PG8_LDB(B1, 0, 1); PG8_STAGE(PG8_SB(0, 0), b2, voffB);
            PG8_BAR; PG8_WAIT_L(0); PG8_MMA(0, 1, At, B1); PG8_BAR;
            PG8_LDA(At, 0, 1); PG8_STAGE(PG8_SA(0, 0), a2, voffA);
            PG8_BAR; PG8_WAIT_L(0); PG8_MMA(1, 0, At, B0); PG8_BAR; PG8_SCHED;
            PG8_STAGE(PG8_SB(0, 1), b2 + hstep, voffB);
            PG8_WAIT_V(6); PG8_BAR; PG8_MMA(1, 1, At, B1); PG8_BAR;
            PG8_LDB(B0, 1, 0); PG8_SCHED; PG8_LDA(At, 1, 0); PG8_STAGE(PG8_SA(0, 1), a2 + hstep, voffA);
            PG8_WAIT_L(8); PG8_BAR; PG8_WAIT_L(0); PG8_MMA(0, 0, At, B0); PG8_BAR; PG8_SCHED;
            PG8_LDB(B1, 1, 1); PG8_STAGE(PG8_SB(1, 0), b3, voffB);
            PG8_BAR; PG8_WAIT_L(0); PG8_MMA(0, 1, At, B1); PG8_BAR;
            PG8_LDA(At, 1, 1); PG8_STAGE(PG8_SA(1, 0), a3, voffA);
            PG8_BAR; PG8_WAIT_L(0); PG8_MMA(1, 0, At, B0); PG8_BAR; PG8_SCHED;
            PG8_STAGE(PG8_SB(1, 1), b3 + hstep, voffB);
            PG8_WAIT_V(6); PG8_BAR; PG8_MMA(1, 1, At, B1); PG8_BAR;
            }
        }
        if constexpr (ALIGN_EPI) { if (wr == 0) PG8_BAR; }
        if constexpr (!Epi::AFTER_DRAIN) { E(acc, cur, wr, wc, fr, fq); S.done(cur); }
        if (!has_next) break;
#pragma unroll
        for (int a = 0; a < 2; ++a)
#pragma unroll
            for (int b = 0; b < 2; ++b)
#pragma unroll
                for (int m = 0; m < 4; ++m)
#pragma unroll
                    for (int n = 0; n < 2; ++n) acc[a][b][m][n] = (f32x4){0.f, 0.f, 0.f, 0.f};
        cur = nxt; cA = nA; cB = nB; ++ui;
        if constexpr (ALIGN_EPI) { if (wr == 1) PG8_BAR; }
    }
    PG8_WAIT_V(0);
    if constexpr (!ALIGN_EPI) { if (wr == 0) PG8_BAR; }
    PG8_BAR;
    if constexpr (Epi::AFTER_DRAIN) { E.fused(acc, cur, wr, wc, fr, fq, lds, wid, lane); S.done(cur); }
#undef PG8_SA
#undef PG8_SB
#undef PG8_STAGE
#undef PG8_LDA
#undef PG8_LDB
#undef PG8_MMA
#undef PG8_WAIT_V
#undef PG8_WAIT_L
#undef PG8_BAR
#undef PG8_SCHED
}
}
#define GAS __attribute__((address_space(1)))
#define LAS __attribute__((address_space(3)))
typedef unsigned short bf16;
typedef unsigned v4u __attribute__((ext_vector_type(4)));
typedef unsigned v2u __attribute__((ext_vector_type(2)));
typedef float f32x4 __attribute__((ext_vector_type(4)));
typedef float f32x2 __attribute__((ext_vector_type(2)));
typedef short bf16x8 __attribute__((ext_vector_type(8)));
#define LDS_WAIT() asm volatile("s_waitcnt lgkmcnt(0)" ::: "memory")
__device__ __forceinline__ unsigned f2bf(float f) { unsigned u = __builtin_bit_cast(unsigned, f); return (u + 0x7fffu + ((u >> 16) & 1u)) >> 16; }
__device__ __forceinline__ unsigned pk2(float lo, float hi) { return f2bf(lo) | (f2bf(hi) << 16); }
__device__ __forceinline__ float bf2f(unsigned short b) { return __uint_as_float(((unsigned)b) << 16); }
__device__ __forceinline__ float lo_bf(unsigned w) { return __uint_as_float(w << 16); }
__device__ __forceinline__ float hi_bf(unsigned w) { return __uint_as_float(w & 0xffff0000u); }
__device__ __forceinline__ float wave_sum(float v) {
#pragma unroll
    for (int o = 1; o < 64; o <<= 1) v += __shfl_xor(v, o);
    return v;
}
__device__ __forceinline__ float sigmoid_f(float x) { return 1.0f / (1.0f + __expf(-x)); }
__device__ __forceinline__ float silu_f(float x) { return x / (1.0f + __expf(-x)); }
__device__ __forceinline__ f32x4 mfma16(bf16x8 a, bf16x8 b, f32x4 c) { return __builtin_amdgcn_mfma_f32_16x16x32_bf16(a, b, c, 0, 0, 0); }
#define XB_TMO      128
#define XB_XCNT(j)  (256  + 64 * (j))
#define XB_XSUB(j)  (1280 + 64 * (j))
#define XB_XGEN(j)  (2304 + 64 * (j))
#define XB_TOP      3328
#define XB_TOPGEN   3392
#define XCD_BAR_WORDS 3456
#define XB_SPIN_CAP (1u << 18)

__device__ __forceinline__ unsigned xb_ld(unsigned* p)              { return __hip_atomic_load(p, __ATOMIC_RELAXED, __HIP_MEMORY_SCOPE_AGENT); }
__device__ __forceinline__ unsigned xb_add(unsigned* p, unsigned v) { return __hip_atomic_fetch_add(p, v, __ATOMIC_RELAXED, __HIP_MEMORY_SCOPE_AGENT); }
__device__ __forceinline__ unsigned xb_xcc_id() { return (unsigned)__builtin_amdgcn_s_getreg((3 << 11) | 20) & 0xFu; }
#define XB_SPIN(cond, bar) do { unsigned _sp = 0; while (cond) { __builtin_amdgcn_s_sleep(1); \
    if ((++_sp & 255u) == 0u) { if (xb_ld(&(bar)[XB_TMO])) break; if (_sp > XB_SPIN_CAP) { atomicAdd(&(bar)[XB_TMO], 1u); break; } } } } while (0)

struct XcdBarrier {
    unsigned* bar; unsigned x;
    volatile LAS unsigned* st;
};

__device__ __forceinline__ XcdBarrier xcd_barrier_post(unsigned* bar, volatile LAS unsigned* st) {
    XcdBarrier b; b.bar = bar; b.x = xb_xcc_id(); b.st = st;
    if (threadIdx.x == 0) (void)xb_add(&bar[XB_XCNT(b.x)], 1u);
    return b;
}
__device__ __forceinline__ void xcd_barrier_complete(unsigned* bar, unsigned x, unsigned& nloc, unsigned& nx) {
    const unsigned G = gridDim.x * gridDim.y * gridDim.z;
    unsigned sum, cnt, mine, sp = 0u;
    for (;;) {
        sum = 0u; cnt = 0u; mine = 0u;
#pragma unroll
        for (unsigned j = 0; j < 16; ++j) { const unsigned c = xb_ld(&bar[XB_XCNT(j)]); sum += c; cnt += (c > 0u) ? 1u : 0u; mine = (j == x) ? c : mine; }
        if (sum == G) break;
        __builtin_amdgcn_s_sleep(1);
        if ((++sp & 255u) == 0u) { if (xb_ld(&bar[XB_TMO])) break; if (sp > XB_SPIN_CAP) { atomicAdd(&bar[XB_TMO], 1u); break; } }
    }
    nloc = mine > 0u ? mine : 1u; nx = cnt > 0u ? cnt : 1u;
}

__device__ __forceinline__ void xcd_barrier(const XcdBarrier& b) {
    asm volatile("s_waitcnt vmcnt(0)" ::: "memory");
    __syncthreads();
    if (threadIdx.x == 0) {
        unsigned* bar = b.bar;
        __builtin_amdgcn_s_waitcnt(0);
        unsigned nloc = b.st[0], nx = b.st[1];
        if (nloc == 0u) { xcd_barrier_complete(bar, b.x, nloc, nx); b.st[0] = nloc; b.st[1] = nx; }
        const unsigned old = xb_add(&bar[XB_XSUB(b.x)], 1u);
        const unsigned gen = old / nloc;
        if (old + 1u == (gen + 1u) * nloc) {
            __builtin_amdgcn_fence(__ATOMIC_RELEASE, "agent");
            asm volatile("s_waitcnt vmcnt(0)" ::: "memory");
            const unsigned og = xb_add(&bar[XB_TOP], 1u);
            const unsigned tg = og / nx;
            if (og + 1u == (tg + 1u) * nx) xb_add(&bar[XB_TOPGEN], 1u);
            else XB_SPIN(xb_ld(&bar[XB_TOPGEN]) == tg, bar);
            __builtin_amdgcn_fence(__ATOMIC_ACQUIRE, "agent");
            xb_add(&bar[XB_XGEN(b.x)], 1u);
            asm volatile("s_waitcnt vmcnt(0)" ::: "memory");
        } else {
            XB_SPIN(xb_ld(&bar[XB_XGEN(b.x)]) == gen, bar);
            __builtin_amdgcn_fence(__ATOMIC_ACQUIRE, "agent");
            asm volatile("s_waitcnt vmcnt(0)" ::: "memory");
        }
    }
    __syncthreads();
}

constexpr int BATCH = 4, SEQ = 2048, DM = 2048, MTOK = BATCH * SEQ, DFF = 5632, PLD = 6144, NIN_E = 5376, NIN_O = 6144;
constexpr int NPH = 34;
constexpr float ALPHA_DN = 1.6817928305074290f;
constexpr float LN_EPS = 1e-5f;
constexpr float LOG2E = 1.4426950408889634f;
constexpr size_t MiB = 1u << 20;
constexpr size_t WS_CTL = 0, CTL_ZERO_BYTES = 1 * MiB;
constexpr size_t WS_WIN = 2 * MiB, WIN_STRIDE = 24 * MiB;
constexpr size_t WS_WOUT = 98 * MiB, WOUT_STRIDE = 8 * MiB;
constexpr size_t WS_WGLU = 130 * MiB, WGLU_STRIDE = 2 * MiB;
constexpr size_t WS_WGU = 134 * MiB, WGU_STRIDE = 44 * MiB;
constexpr size_t WS_WDN = 310 * MiB, WDN_STRIDE = 22 * MiB;
constexpr size_t WS_X = 398 * MiB;
constexpr size_t WS_H = 462 * MiB;
constexpr size_t WS_PROJ = 494 * MiB;
constexpr size_t WS_MIX = 590 * MiB;
constexpr size_t WS_Y = 622 * MiB;
constexpr size_t WS_HID = 686 * MiB;
constexpr size_t WS_MOD = 774 * MiB;
constexpr size_t WS_YPRE = 775 * MiB;
constexpr size_t WS_ODN = 791 * MiB;
constexpr size_t WS_CHU = 823 * MiB, WS_CHW = 839 * MiB, WS_CHQD = 855 * MiB, WS_CHKT = 871 * MiB;
constexpr size_t WS_CHA = 887 * MiB;
constexpr size_t WS_CHGL = 895 * MiB;
constexpr size_t WS_S5END = 896 * MiB;
constexpr size_t WS_END = 897 * MiB;
constexpr int CW_BAR = 4096;
constexpr int LDS_BYTES = 147456, LDS_MISC = 143360;

struct Args { const float* in[34]; float* out; unsigned char* ws; int ph_lo, ph_hi; };

__device__ __forceinline__ int dest_row(int mode, int n) {
    if (mode == 1) return n < 4096 ? n : (n < 4112 ? n + 1024 : n - 16);
    if (mode == 2) return ((n >> 7) << 8) + (n & 127);
    if (mode == 3) return ((n >> 7) << 8) + 128 + (n & 127);
    return n;
}
__device__ __forceinline__ void transpose_item(const float* __restrict__ W, int K, int N, bf16* WT, int mode, LAS float* scr, int kb, int nb, int lane) {
    const int k0 = kb * 64, n0 = nb * 64, cq = lane & 15, rq = lane >> 4, n = n0 + 4 * cq;
#pragma unroll 4
    for (int i = 0; i < 16; ++i) { const int kk = 4 * i + rq; f32x4 v = (f32x4){0.f, 0.f, 0.f, 0.f};
        if (n < N) v = *(const f32x4*)(W + (size_t)(k0 + kk) * N + n);
        LAS float* s = scr + kk * 65 + 4 * cq; s[0] = v.x; s[1] = v.y; s[2] = v.z; s[3] = v.w; }
    LDS_WAIT();
    const int c = lane & 7;
#pragma unroll
    for (int j = 0; j < 8; ++j) { const int nn = 8 * j + (lane >> 3), ng = n0 + nn;
        if (ng < N) { const LAS float* s = scr + (8 * c) * 65 + nn;
            v4u o; o.x = pk2(s[0], s[65]); o.y = pk2(s[130], s[195]); o.z = pk2(s[260], s[325]); o.w = pk2(s[390], s[455]);
            *(v4u*)(WT + (size_t)dest_row(mode, ng) * K + k0 + 8 * c) = o; } }
    LDS_WAIT();
}
__device__ __forceinline__ void p0a_phase(LAS unsigned char* lds, const Args& A, int G) {
    int tid_ = threadIdx.x; asm volatile("" : "+v"(tid_)); const int tid = tid_, lane = tid & 63, wave = __builtin_amdgcn_readfirstlane(tid >> 6);
    unsigned char* ws = A.ws;
    {
        LAS float* cact = (LAS float*)lds;
        LAS float* red = (LAS float*)(lds + 32768);
        const float* c = A.in[1]; const float* ada_w = A.in[2]; const float* ada_b = A.in[3]; float* MOD = (float*)(ws + WS_MOD);
        for (int e = tid; e < 4 * 2048; e += 512) { const float cv = c[e]; cact[e] = cv / (1.0f + expf(-cv)); }
        __syncthreads();
        for (int it = blockIdx.x; it < 192; it += G) {
            const int layer = it / 48, cg = it % 48;
            const float* Wl = ada_w + (size_t)layer * 2048 * 12288 + cg * 256 + 4 * lane;
            f32x4 acc[4];
#pragma unroll
            for (int b = 0; b < 4; ++b) acc[b] = (f32x4){0.f, 0.f, 0.f, 0.f};
            const int kbeg = wave * 256;
#pragma unroll 2
            for (int k = kbeg; k < kbeg + 256; k += 4) {
                const f32x4 w0 = *(const f32x4*)(Wl + (size_t)(k + 0) * 12288), w1 = *(const f32x4*)(Wl + (size_t)(k + 1) * 12288);
                const f32x4 w2 = *(const f32x4*)(Wl + (size_t)(k + 2) * 12288), w3 = *(const f32x4*)(Wl + (size_t)(k + 3) * 12288);
#pragma unroll
                for (int b = 0; b < 4; ++b) { const f32x4 cv = *(const LAS f32x4*)(cact + b * 2048 + k); acc[b] += cv.x * w0 + cv.y * w1 + cv.z * w2 + cv.w * w3; }
            }
#pragma unroll
            for (int b = 0; b < 4; ++b) *(LAS f32x4*)(red + (wave * 4 + b) * 256 + 4 * lane) = acc[b];
            __syncthreads();
            { const int b = tid >> 7, c0 = 2 * (tid & 127); float s0 = 0.f, s1 = 0.f;
#pragma unroll
              for (int w = 0; w < 8; ++w) { s0 += red[(w * 4 + b) * 256 + c0]; s1 += red[(w * 4 + b) * 256 + c0 + 1]; }
              const int col = cg * 256 + c0;
              MOD[(size_t)(layer * 4 + b) * 12288 + col] = s0 + ada_b[layer * 12288 + col];
              MOD[(size_t)(layer * 4 + b) * 12288 + col + 1] = s1 + ada_b[layer * 12288 + col + 1]; }
            __syncthreads();
        }
    }
    {
        LAS float* scr = (LAS float*)(lds + wave * 16896);
        const int gw = blockIdx.x * 8 + wave, NGW = G * 8;
        constexpr int I_FF = 32 * 88, I_ABI = 32 * 81, I_CDI = 32 * 96, I_OUT = 32 * 32, I_GLU = 16 * 16;
        constexpr int NITEMS = 12 * I_FF + 2 * I_ABI + 2 * I_CDI + 4 * I_OUT + 2 * I_GLU;
        for (int it = gw; it < NITEMS; it += NGW) {
            int r = it;
            const float* W; int K, N, mode, NB; bf16* WT;
            if (r < 4 * I_FF) { const int l = r / I_FF; r -= l * I_FF; W = A.in[8] + (size_t)l * 2048 * DFF; K = 2048; N = DFF; mode = 2; NB = 88; WT = (bf16*)(ws + WS_WGU + l * WGU_STRIDE); }
            else if ((r -= 4 * I_FF) < 4 * I_FF) { const int l = r / I_FF; r -= l * I_FF; W = A.in[9] + (size_t)l * 2048 * DFF; K = 2048; N = DFF; mode = 3; NB = 88; WT = (bf16*)(ws + WS_WGU + l * WGU_STRIDE); }
            else if ((r -= 4 * I_FF) < 4 * I_FF) { const int l = r / I_FF; r -= l * I_FF; W = A.in[10] + (size_t)l * DFF * 2048; K = DFF; N = 2048; mode = 0; NB = 32; WT = (bf16*)(ws + WS_WDN + l * WDN_STRIDE); }
            else if ((r -= 4 * I_FF) < 2 * I_ABI) { const int j = r / I_ABI; r -= j * I_ABI; W = A.in[11] + (size_t)j * 2048 * 5136; K = 2048; N = 5136; mode = 1; NB = 81; WT = (bf16*)(ws + WS_WIN + (2 * j) * WIN_STRIDE); }
            else if ((r -= 2 * I_ABI) < 2 * I_CDI) { const int j = r / I_CDI; r -= j * I_CDI; W = A.in[26] + (size_t)j * 2048 * 6144; K = 2048; N = 6144; mode = 0; NB = 96; WT = (bf16*)(ws + WS_WIN + (2 * j + 1) * WIN_STRIDE); }
            else if ((r -= 2 * I_CDI) < 2 * I_OUT) { const int j = r / I_OUT; r -= j * I_OUT; W = A.in[12] + (size_t)j * 2048 * 2048; K = 2048; N = 2048; mode = 0; NB = 32; WT = (bf16*)(ws + WS_WOUT + (2 * j) * WOUT_STRIDE); }
            else if ((r -= 2 * I_OUT) < 2 * I_OUT) { const int j = r / I_OUT; r -= j * I_OUT; W = A.in[27] + (size_t)j * 2048 * 2048; K = 2048; N = 2048; mode = 0; NB = 32; WT = (bf16*)(ws + WS_WOUT + (2 * j + 1) * WOUT_STRIDE); }
            else { r -= 2 * I_OUT; const int j = r / I_GLU; r -= j * I_GLU; W = A.in[25] + (size_t)j * 1024 * 1024; K = 1024; N = 1024; mode = 0; NB = 16; WT = (bf16*)(ws + WS_WGLU + j * WGLU_STRIDE); }
            transpose_item(W, K, N, WT, mode, scr, r / NB, r % NB, lane);
        }
    }
}
__device__ __forceinline__ void modulate_phase(const float* X, const float* MODl  , int sh_off, int sc_off, bf16* H, int G) {
    const size_t nth = (size_t)G * 512;
    int tid_ = threadIdx.x; asm volatile("" : "+v"(tid_));
    for (size_t e = (size_t)blockIdx.x * 512 + tid_; e < (size_t)MTOK * DM / 8; e += nth) {
        const int m = (int)(e >> 8), c8 = (int)(e & 255) * 8, b = m >> 11;
        const f32x4 x0 = *(const f32x4*)(X + (size_t)m * DM + c8), x1 = *(const f32x4*)(X + (size_t)m * DM + c8 + 4);
        const float* mb = MODl + (size_t)b * 12288;
        const f32x4 s0 = *(const f32x4*)(mb + sc_off + c8), s1 = *(const f32x4*)(mb + sc_off + c8 + 4);
        const f32x4 h0 = *(const f32x4*)(mb + sh_off + c8), h1 = *(const f32x4*)(mb + sh_off + c8 + 4);
        const f32x4 o0 = x0 * (1.0f + s0) + h0, o1 = x1 * (1.0f + s1) + h1;
        v4u w; w.x = pk2(o0.x, o0.y); w.y = pk2(o0.z, o0.w); w.z = pk2(o1.x, o1.y); w.w = pk2(o1.z, o1.w);
        *(v4u*)(H + (size_t)m * DM + c8) = w;
    }
}
__device__ __forceinline__ void ln_phase(const float* Xin, const float* Y, float* Xout, bf16* H, const float* MODg  ,
                                         const float* lng, const float* lnb, const float* MODn  , int sh_off, int sc_off, int G) {
    int tid_ = threadIdx.x; asm volatile("" : "+v"(tid_)); const int lane = tid_ & 63, gw = blockIdx.x * 8 + (tid_ >> 6), NGW = G * 8;
    for (int m = gw; m < MTOK; m += NGW) {
        const int b = m >> 11;
        const float* xr = Xin + (size_t)m * DM + 4 * lane; const float* yr = Y + (size_t)m * DM + 4 * lane; const float* gr = MODg + (size_t)b * 12288 + 4 * lane;
        f32x4 v[8]; float s = 0.f;
#pragma unroll
        for (int j = 0; j < 8; ++j) { const f32x4 x = *(const f32x4*)(xr + 256 * j), y = *(const f32x4*)(yr + 256 * j), g = *(const f32x4*)(gr + 256 * j);
            v[j] = ALPHA_DN * x + (1.0f + g) * y; s += (v[j].x + v[j].y) + (v[j].z + v[j].w); }
        const float mean = wave_sum(s) * (1.0f / DM); float s2 = 0.f;
#pragma unroll
        for (int j = 0; j < 8; ++j) { v[j] = v[j] - mean; s2 += (v[j].x * v[j].x + v[j].y * v[j].y) + (v[j].z * v[j].z + v[j].w * v[j].w); }
        const float rstd = 1.0f / sqrtf(wave_sum(s2) * (1.0f / DM) + LN_EPS);
#pragma unroll
        for (int j = 0; j < 8; ++j) { const int col = 4 * lane + 256 * j;
            const f32x4 o = v[j] * rstd * *(const f32x4*)(lng + col) + *(const f32x4*)(lnb + col);
            *(f32x4*)(Xout + (size_t)m * DM + col) = o;
            if (MODn) { const float* mb = MODn + (size_t)b * 12288 + col; const f32x4 hh = o * (1.0f + *(const f32x4*)(mb + sc_off)) + *(const f32x4*)(mb + sh_off);
                v2u w; w.x = pk2(hh.x, hh.y); w.y = pk2(hh.z, hh.w); *(v2u*)(H + (size_t)m * DM + col) = w; } }
    }
}

__device__ __forceinline__ void shortconv_phase(const bf16* PROJ, const float* cw  , bf16* MIX, int G) {
    const size_t nth = (size_t)G * 512;
    int tid_ = threadIdx.x; asm volatile("" : "+v"(tid_));
    for (size_t e = (size_t)blockIdx.x * 512 + tid_; e < (size_t)MTOK * 128; e += nth) {
        const int m = (int)(e >> 7), c8 = (int)(e & 127) * 8, t = m & (SEQ - 1);
        float acc[8];
#pragma unroll
        for (int i = 0; i < 8; ++i) acc[i] = 0.f;
#pragma unroll
        for (int kk = 0; kk < 3; ++kk) {
            if (t - 2 + kk >= 0) {
                const bf16* row = PROJ + (size_t)(m - 2 + kk) * PLD;
                const v4u g = *(const v4u*)(row + 1024 + c8), x = *(const v4u*)(row + 2048 + c8);
                const f32x4 w0 = *(const f32x4*)(cw + kk * 1024 + c8), w1 = *(const f32x4*)(cw + kk * 1024 + c8 + 4);
                acc[0] += w0.x * lo_bf(g.x) * lo_bf(x.x); acc[1] += w0.y * hi_bf(g.x) * hi_bf(x.x);
                acc[2] += w0.z * lo_bf(g.y) * lo_bf(x.y); acc[3] += w0.w * hi_bf(g.y) * hi_bf(x.y);
                acc[4] += w1.x * lo_bf(g.z) * lo_bf(x.z); acc[5] += w1.y * hi_bf(g.z) * hi_bf(x.z);
                acc[6] += w1.z * lo_bf(g.w) * lo_bf(x.w); acc[7] += w1.w * hi_bf(g.w) * hi_bf(x.w);
            }
        }
        const v4u gb = *(const v4u*)(PROJ + (size_t)m * PLD + c8);
        v4u w; w.x = pk2(lo_bf(gb.x) * acc[0], hi_bf(gb.x) * acc[1]); w.y = pk2(lo_bf(gb.y) * acc[2], hi_bf(gb.y) * acc[3]);
        w.z = pk2(lo_bf(gb.z) * acc[4], hi_bf(gb.z) * acc[5]); w.w = pk2(lo_bf(gb.w) * acc[6], hi_bf(gb.w) * acc[7]);
        *(v4u*)(MIX + (size_t)m * DM + c8) = w;
    }
}

__device__ __forceinline__ void attn_phase(LAS unsigned char* lds, const bf16* PROJ, bf16* MIX, const float* lq1, const float* lk1, const float* lq2, const float* lk2,
                                           const float* norm_g, float lambda_init, int G) {
    int tid_ = threadIdx.x; asm volatile("" : "+v"(tid_)); const int tid = tid_, lane = tid & 63, w = __builtin_amdgcn_readfirstlane(tid >> 6), q4 = lane >> 4, l15 = lane & 15, mi = w >> 2, wq = w & 3;
    float lam;
    { float s1 = lq1[lane] * lk1[lane] + lq1[lane + 64] * lk1[lane + 64], s2 = lq2[lane] * lk2[lane] + lq2[lane + 64] * lk2[lane + 64];
      s1 = wave_sum(s1); s2 = wave_sum(s2); lam = expf(s1) - expf(s2) + lambda_init; }
    LAS unsigned char* K0 = lds; LAS unsigned char* K1 = lds + 17408; LAS unsigned char* VT = lds + 34816; LAS unsigned char* XCH = lds;
    LAS unsigned char* Kmine = mi ? K1 : K0;
    const float c1 = 0.08838834764831845f * LOG2E;
    for (int u = blockIdx.x; u < 256; u += G) {
        const int b = u >> 6, h = (u >> 4) & 3, p = u & 15;
        const float sl2 = exp2f(-2.0f * (float)(h + 1)) * LOG2E;
        const bf16* base = PROJ + (size_t)b * SEQ * PLD;
        for (int half = 0; half < 2; ++half) {
            const int qb = half ? 31 - p : p;
            const int qloc = 16 * wq + l15;
            bf16x8 qf[4];
            { const bf16* qp = base + (size_t)(64 * qb + qloc) * PLD + 3072 + h * 256 + mi * 128 + 8 * q4;
#pragma unroll
              for (int sk = 0; sk < 4; ++sk) qf[sk] = *(const bf16x8*)(qp + 32 * sk); }
            f32x4 O[16];
#pragma unroll
            for (int mt = 0; mt < 16; ++mt) O[mt] = (f32x4){0.f, 0.f, 0.f, 0.f};
            float m_run = -1e30f, l_part = 0.f;
            v4u rk0[2], rk1[2], rv[4];
#define ATT_LOAD(kt_) do { const bf16* tb = base + (size_t)(64 * (kt_)) * PLD + h * 256; \
                _Pragma("unroll") for (int j = 0; j < 2; ++j) { const int c = tid + 512 * j, key = c >> 4, ch = c & 15; \
                    rk0[j] = *(const v4u*)(tb + (size_t)key * PLD + 4096 + 8 * ch); rk1[j] = *(const v4u*)(tb + (size_t)key * PLD + 4096 + 128 + 8 * ch); } \
                _Pragma("unroll") for (int j = 0; j < 4; ++j) { const int c = tid + 512 * j, key = c >> 5, ch = c & 31; rv[j] = *(const v4u*)(tb + (size_t)key * PLD + 5120 + 8 * ch); } } while (0)
            ATT_LOAD(0);
            for (int kt = 0; kt <= qb; ++kt) {
                __syncthreads();
#pragma unroll
                for (int j = 0; j < 2; ++j) { const int c = tid + 512 * j, key = c >> 4, ch = c & 15;
                    *(LAS v4u*)(K0 + key * 272 + ch * 16) = rk0[j]; *(LAS v4u*)(K1 + key * 272 + ch * 16) = rk1[j]; }
#pragma unroll
                for (int j = 0; j < 4; ++j) { const int c = tid + 512 * j, key = c >> 5, ch = c & 31;
                    LAS unsigned short* vp = (LAS unsigned short*)VT + (8 * ch) * 72 + key;
                    vp[0 * 72] = (unsigned short)(rv[j].x & 0xffffu); vp[1 * 72] = (unsigned short)(rv[j].x >> 16);
                    vp[2 * 72] = (unsigned short)(rv[j].y & 0xffffu); vp[3 * 72] = (unsigned short)(rv[j].y >> 16);
                    vp[4 * 72] = (unsigned short)(rv[j].z & 0xffffu); vp[5 * 72] = (unsigned short)(rv[j].z >> 16);
                    vp[6 * 72] = (unsigned short)(rv[j].w & 0xffffu); vp[7 * 72] = (unsigned short)(rv[j].w >> 16); }
                __syncthreads();
                if (kt < qb) ATT_LOAD(kt + 1);
                f32x4 s[4];
#pragma unroll
                for (int t16 = 0; t16 < 4; ++t16) { f32x4 acc = (f32x4){0.f, 0.f, 0.f, 0.f};
#pragma unroll
                    for (int sk = 0; sk < 4; ++sk) { const bf16x8 a = *(const LAS bf16x8*)(Kmine + (16 * t16 + l15) * 272 + (32 * sk + 8 * q4) * 2); acc = mfma16(a, qf[sk], acc); }
                    s[t16] = acc; }
                const int dq = 64 * (qb - kt) + qloc; const bool diag = (kt == qb);
                float mx = -1e30f;
#pragma unroll
                for (int t16 = 0; t16 < 4; ++t16)
#pragma unroll
                    for (int r = 0; r < 4; ++r) { const int kl = 16 * t16 + 4 * q4 + r; float v = s[t16][r] * c1 - sl2 * (float)(dq - kl);
                        if (diag && kl > qloc) v = -1e30f; s[t16][r] = v; mx = fmaxf(mx, v); }
                mx = fmaxf(mx, __shfl_xor(mx, 16)); mx = fmaxf(mx, __shfl_xor(mx, 32));
                const float mn = fmaxf(m_run, mx), alpha = __builtin_amdgcn_exp2f(m_run - mn); m_run = mn;
                float ps = 0.f;
#pragma unroll
                for (int t16 = 0; t16 < 4; ++t16)
#pragma unroll
                    for (int r = 0; r < 4; ++r) { const float pv = __builtin_amdgcn_exp2f(s[t16][r] - mn); s[t16][r] = pv; ps += pv; }
                l_part = l_part * alpha + ps;
#pragma unroll
                for (int mt = 0; mt < 16; ++mt) O[mt] = O[mt] * alpha;
                bf16x8 pf[2];
#pragma unroll
                for (int ks = 0; ks < 2; ++ks) { v4u pw; pw.x = pk2(s[2 * ks][0], s[2 * ks][1]); pw.y = pk2(s[2 * ks][2], s[2 * ks][3]); pw.z = pk2(s[2 * ks + 1][0], s[2 * ks + 1][1]); pw.w = pk2(s[2 * ks + 1][2], s[2 * ks + 1][3]);
                    pf[ks] = __builtin_bit_cast(bf16x8, pw); }
#pragma unroll
                for (int mt = 0; mt < 16; ++mt)
#pragma unroll
                    for (int ks = 0; ks < 2; ++ks) { const LAS unsigned char* vp = VT + (16 * mt + l15) * 144 + (32 * ks + 4 * q4) * 2;
                        const v2u a0 = *(const LAS v2u*)vp, a1 = *(const LAS v2u*)(vp + 32);
                        v4u aw; aw.x = a0.x; aw.y = a0.y; aw.z = a1.x; aw.w = a1.y;
                        O[mt] = mfma16(__builtin_bit_cast(bf16x8, aw), pf[ks], O[mt]); }
            }
#undef ATT_LOAD
            float lt = l_part; lt += __shfl_xor(lt, 16); lt += __shfl_xor(lt, 32); const float inv = 1.0f / lt;
            __syncthreads();
            if (mi == 1) {
#pragma unroll
                for (int mt = 0; mt < 16; ++mt) *(LAS f32x4*)(XCH + ((wq * 16 + mt) * 64 + lane) * 16) = O[mt] * inv;
            }
            __syncthreads();
            if (mi == 0) {
                float ss = 0.f;
#pragma unroll
                for (int mt = 0; mt < 16; ++mt) { const f32x4 o1 = *(const LAS f32x4*)(XCH + ((wq * 16 + mt) * 64 + lane) * 16); const f32x4 o = O[mt] * inv - lam * o1; O[mt] = o;
                    ss += (o.x * o.x + o.y * o.y) + (o.z * o.z + o.w * o.w); }
                ss += __shfl_xor(ss, 16); ss += __shfl_xor(ss, 32);
                const float rs = (1.0f / sqrtf(ss * (1.0f / 256.0f) + LN_EPS)) * (1.0f - lambda_init);
                bf16* orow = MIX + (size_t)(b * SEQ + 64 * qb + qloc) * DM + 1024 + h * 256 + 4 * q4;
#pragma unroll
                for (int mt = 0; mt < 16; ++mt) { const f32x4 g = *(const f32x4*)(norm_g + 16 * mt + 4 * q4); const f32x4 o = O[mt] * rs * g;
                    v2u wv; wv.x = pk2(o.x, o.y); wv.y = pk2(o.z, o.w); *(v2u*)(orow + 16 * mt) = wv; }
            }
            __syncthreads();
        }
    }
}

__device__ __forceinline__ float softplus_f(float x) { return x > 20.0f ? x : log1pf(expf(x)); }
__device__ __forceinline__ void dn_prep_phase(LAS unsigned char* lds, const bf16* PROJ, const float* conv_w  , const float* a_log, const float* dt_bias,
                                              bf16* CHU, bf16* CHW, bf16* CHQD, bf16* CHKT, bf16* CHA, float* CHGL, int G) {
    int tid_ = threadIdx.x; asm volatile("" : "+v"(tid_)); const int tid = tid_, lane = tid & 63, w = __builtin_amdgcn_readfirstlane(tid >> 6), q4 = lane >> 4, l15 = lane & 15;
    LAS unsigned char* Q16 = lds; LAS unsigned char* K16 = lds + 17408;
    LAS float* VF = (LAS float*)(lds + 34816); LAS float* WF = (LAS float*)(lds + 68608);
    LAS float* LF = (LAS float*)(lds + 102400);
    LAS float* RQ = (LAS float*)(lds + 119808); LAS float* RK = RQ + 64; LAS float* BETA = RQ + 128; LAS float* GC = RQ + 192;
    for (int u = blockIdx.x; u < 1024; u += G) {
        const int b = u >> 8, h = (u >> 5) & 7, n = u & 31, m0 = b * SEQ + 64 * n, t0 = 64 * n;
#pragma unroll
        for (int sel = 0; sel < 3; ++sel) {
            const int col = sel * 1024 + h * 128 + 2 * lane;
            float cw0[4], cw1[4];
#pragma unroll
            for (int kk = 0; kk < 4; ++kk) { const f32x2 c2 = *(const f32x2*)(conv_w + kk * 3072 + col); cw0[kk] = c2.x; cw1[kk] = c2.y; }
            unsigned xr[11];
#pragma unroll
            for (int r = 0; r < 11; ++r) { const int tl = 8 * w + r - 3; xr[r] = (t0 + tl >= 0) ? *(const unsigned*)(PROJ + (size_t)(m0 + tl) * PLD + col) : 0u; }
#pragma unroll
            for (int t = 0; t < 8; ++t) {
                float y0 = 0.f, y1 = 0.f;
#pragma unroll
                for (int kk = 0; kk < 4; ++kk) { y0 += cw0[kk] * lo_bf(xr[t + kk]); y1 += cw1[kk] * hi_bf(xr[t + kk]); }
                y0 = silu_f(y0); y1 = silu_f(y1);
                const int i = 8 * w + t;
                if (sel < 2) { const float ss = wave_sum(y0 * y0 + y1 * y1); const float r = 1.0f / sqrtf(ss + 1e-6f);
                    if (lane == 0) { if (sel == 0) RQ[i] = r * 0.08838834764831845f; else RK[i] = r; }
                    *(LAS unsigned*)((sel == 0 ? Q16 : K16) + i * 272 + lane * 4) = pk2(y0, y1); }
                else *(LAS f32x2*)(VF + i * 132 + 2 * lane) = (f32x2){y0, y1};
            }
        }
        if (w == 0) {
            const float bv = bf2f(PROJ[(size_t)(m0 + lane) * PLD + 5120 + h]), av = bf2f(PROJ[(size_t)(m0 + lane) * PLD + 5128 + h]);
            float g = -expf(a_log[h]) * softplus_f(av + dt_bias[h]);
#pragma unroll
            for (int o = 1; o < 64; o <<= 1) { const float tv = __shfl_up(g, o); if (lane >= o) g += tv; }
            BETA[lane] = sigmoid_f(bv); GC[lane] = g;
        }
        __syncthreads();
        {
            const int prod = w >> 2, mt = w & 3; const LAS unsigned char* Ab = prod ? Q16 : K16;
            bf16x8 af[4];
#pragma unroll
            for (int sk = 0; sk < 4; ++sk) af[sk] = *(const LAS bf16x8*)(Ab + (16 * mt + l15) * 272 + (32 * sk + 8 * q4) * 2);
#pragma unroll
            for (int nt = 0; nt < 4; ++nt) { f32x4 acc = (f32x4){0.f, 0.f, 0.f, 0.f};
#pragma unroll
                for (int sk = 0; sk < 4; ++sk) { const bf16x8 bb = *(const LAS bf16x8*)(K16 + (16 * nt + l15) * 272 + (32 * sk + 8 * q4) * 2); acc = mfma16(af[sk], bb, acc); }
                const int jn = 16 * nt + l15; const float rkj = RK[jn], gj = GC[jn];
#pragma unroll
                for (int r = 0; r < 4; ++r) { const int i = 16 * mt + 4 * q4 + r; const float dec = expf(fminf(GC[i] - gj, 0.0f));
                    if (prod == 0) LF[i * 68 + jn] = (jn < i) ? acc[r] * BETA[i] * RK[i] * rkj * dec : 0.0f;
                    else CHA[(size_t)u * 4096 + i * 64 + jn] = (bf16)f2bf((jn <= i) ? acc[r] * RQ[i] * rkj * dec : 0.0f); }
            }
        }
#pragma unroll 4
        for (int it = 0; it < 16; ++it) { const int e = tid + 512 * it, i = e >> 7, d = e & 127;
            const float kn = bf2f(*(const LAS unsigned short*)(K16 + i * 272 + d * 2)) * RK[i], qn = bf2f(*(const LAS unsigned short*)(Q16 + i * 272 + d * 2)) * RQ[i];
            const float eg = expf(GC[i]), be = BETA[i];
            CHQD[(size_t)u * 8192 + e] = (bf16)f2bf(qn * eg);
            WF[i * 132 + d] = kn * be * eg; VF[i * 132 + d] *= be; }
#pragma unroll 4
        for (int it = 0; it < 16; ++it) { const int e = tid + 512 * it, d = e >> 6, i = e & 63;
            const float kn = bf2f(*(const LAS unsigned short*)(K16 + i * 272 + d * 2)) * RK[i];
            CHKT[(size_t)u * 8192 + e] = (bf16)f2bf(kn * expf(GC[63] - GC[i])); }
        __syncthreads();
        if (tid < 256) {
            const LAS float* X = (tid < 128) ? (VF + tid) : (WF + (tid - 128));
            const LAS float* LFo = LF; asm volatile("" : "+v"(LFo)); asm volatile("" : "+v"(X));
            float x[64];
#pragma unroll
            for (int i = 0; i < 64; ++i) {
                float acc = X[i * 132];
#pragma unroll
                for (int jb = 0; jb < (i + 3) / 4; ++jb) { const f32x4 l4 = *(const LAS f32x4*)(LFo + i * 68 + 4 * jb);
                    if (4 * jb + 0 < i) acc -= l4.x * x[4 * jb + 0];
                    if (4 * jb + 1 < i) acc -= l4.y * x[4 * jb + 1];
                    if (4 * jb + 2 < i) acc -= l4.z * x[4 * jb + 2];
                    if (4 * jb + 3 < i) acc -= l4.w * x[4 * jb + 3]; }
                x[i] = acc;
            }
            bf16* dst = (tid < 128) ? (CHU + (size_t)u * 8192 + tid) : (CHW + (size_t)u * 8192 + (tid - 128));
#pragma unroll
            for (int i = 0; i < 64; ++i) dst[i * 128] = (bf16)f2bf(x[i]);
            if (tid == 0) CHGL[u] = expf(GC[63]);
        }
        __syncthreads();
    }
}

__device__ __forceinline__ void dn_scan_phase(LAS unsigned char* lds, const bf16* CHU, const bf16* CHW, const bf16* CHQD, const bf16* CHKT, const bf16* CHA, const float* CHGL, float* ODN, int G) {
    int tid_ = threadIdx.x; asm volatile("" : "+v"(tid_)); const int tid = tid_, lane = tid & 63, w = __builtin_amdgcn_readfirstlane(tid >> 6), q4 = lane >> 4, l15 = lane & 15;
    LAS unsigned char* Wt = lds; LAS unsigned char* QDt = lds + 17408; LAS unsigned char* KTt = lds + 34816; LAS unsigned char* At = lds + 53248;
    LAS unsigned char* Ut = lds + 62464; LAS unsigned char* St = lds + 67584; LAS unsigned char* VNt = lds + 76288;
    const int mt = w >> 1, nt = w & 1;
    for (int u = blockIdx.x; u < 128; u += G) {
        const int bh = u >> 2, sl = u & 3, b = bh >> 3, h = bh & 7;
        __syncthreads();
        for (int e = tid; e < 8704 / 4; e += 512) ((LAS unsigned*)St)[e] = 0u;
        f32x4 Sr[2]; Sr[0] = (f32x4){0.f, 0.f, 0.f, 0.f}; Sr[1] = (f32x4){0.f, 0.f, 0.f, 0.f};
        v4u rw[2], rq[2], rk[2], ra, ru;
        ru = (v4u){0u, 0u, 0u, 0u};
#define DNS_LOAD(ch_) do { const size_t cb = (size_t)(ch_) * 8192; \
            _Pragma("unroll") for (int j = 0; j < 2; ++j) { const int c = tid + 512 * j; rw[j] = *(const v4u*)(CHW + cb + 8 * c); rq[j] = *(const v4u*)(CHQD + cb + 8 * c); rk[j] = *(const v4u*)(CHKT + cb + 8 * c); } \
            ra = *(const v4u*)(CHA + (size_t)(ch_) * 4096 + 8 * tid); \
            if (tid < 256) ru = *(const v4u*)(CHU + cb + (tid >> 2) * 128 + 32 * sl + (tid & 3) * 8); } while (0)
        DNS_LOAD(bh * 32);
        for (int n = 0; n < 32; ++n) {
            const int chunk = bh * 32 + n, m0 = b * SEQ + 64 * n;
#pragma unroll
            for (int j = 0; j < 2; ++j) { const int c = tid + 512 * j;
                *(LAS v4u*)(Wt + (c >> 4) * 272 + (c & 15) * 16) = rw[j]; *(LAS v4u*)(QDt + (c >> 4) * 272 + (c & 15) * 16) = rq[j];
                *(LAS v4u*)(KTt + (c >> 3) * 144 + (c & 7) * 16) = rk[j]; }
            *(LAS v4u*)(At + (tid >> 3) * 144 + (tid & 7) * 16) = ra;
            if (tid < 256) *(LAS v4u*)(Ut + (tid >> 2) * 80 + (tid & 3) * 16) = ru;
            __syncthreads();
            if (n < 31) DNS_LOAD(chunk + 1);
            const float gl = CHGL[chunk];
            {
                f32x4 acc = (f32x4){0.f, 0.f, 0.f, 0.f};
#pragma unroll
                for (int sk = 0; sk < 4; ++sk) { const bf16x8 a = *(const LAS bf16x8*)(Wt + (16 * mt + l15) * 272 + (32 * sk + 8 * q4) * 2);
                    const bf16x8 bb = *(const LAS bf16x8*)(St + (16 * nt + l15) * 272 + (32 * sk + 8 * q4) * 2); acc = mfma16(a, bb, acc); }
                float vn[4];
#pragma unroll
                for (int r = 0; r < 4; ++r) vn[r] = bf2f(*(const LAS unsigned short*)(Ut + (16 * mt + 4 * q4 + r) * 80 + (16 * nt + l15) * 2)) - acc[r];
                v2u pw; pw.x = pk2(vn[0], vn[1]); pw.y = pk2(vn[2], vn[3]);
                *(LAS v2u*)(VNt + (16 * nt + l15) * 144 + (16 * mt + 4 * q4) * 2) = pw;
            }
            __syncthreads();
            {
                f32x4 acc = (f32x4){0.f, 0.f, 0.f, 0.f};
#pragma unroll
                for (int sk = 0; sk < 4; ++sk) { const bf16x8 a = *(const LAS bf16x8*)(QDt + (16 * mt + l15) * 272 + (32 * sk + 8 * q4) * 2);
                    const bf16x8 bb = *(const LAS bf16x8*)(St + (16 * nt + l15) * 272 + (32 * sk + 8 * q4) * 2); acc = mfma16(a, bb, acc); }
#pragma unroll
                for (int sk = 0; sk < 2; ++sk) { const bf16x8 a = *(const LAS bf16x8*)(At + (16 * mt + l15) * 144 + (32 * sk + 8 * q4) * 2);
                    const bf16x8 bb = *(const LAS bf16x8*)(VNt + (16 * nt + l15) * 144 + (32 * sk + 8 * q4) * 2); acc = mfma16(a, bb, acc); }
                float* op = ODN + (size_t)(m0 + 16 * mt + 4 * q4) * 1024 + h * 128 + 32 * sl + 16 * nt + l15;
#pragma unroll
                for (int r = 0; r < 4; ++r) op[(size_t)r * 1024] = acc[r];
            }
#pragma unroll
            for (int dvt = 0; dvt < 2; ++dvt) { f32x4 acc = Sr[dvt] * gl;
#pragma unroll
                for (int sk = 0; sk < 2; ++sk) { const bf16x8 a = *(const LAS bf16x8*)(KTt + (16 * w + l15) * 144 + (32 * sk + 8 * q4) * 2);
                    const bf16x8 bb = *(const LAS bf16x8*)(VNt + (16 * dvt + l15) * 144 + (32 * sk + 8 * q4) * 2); acc = mfma16(a, bb, acc); }
                Sr[dvt] = acc; }
            __syncthreads();
#pragma unroll
            for (int dvt = 0; dvt < 2; ++dvt) { v2u pw; pw.x = pk2(Sr[dvt][0], Sr[dvt][1]); pw.y = pk2(Sr[dvt][2], Sr[dvt][3]);
                *(LAS v2u*)(St + (16 * dvt + l15) * 272 + (16 * w + 4 * q4) * 2) = pw; }
        }
#undef DNS_LOAD
    }
}
__device__ __forceinline__ void dn_gate_phase(const float* ODN, const bf16* PROJ, const float* norm_g, bf16* MIX, int G) {
    int tid_ = threadIdx.x; asm volatile("" : "+v"(tid_)); const int lane = tid_ & 63, gw = blockIdx.x * 8 + (tid_ >> 6), NGW = G * 8;
    const f32x2 g2 = *(const f32x2*)(norm_g + 2 * lane);
    for (int it = gw; it < MTOK * 8; it += NGW) { const int m = it >> 3, h = it & 7;
        const f32x2 o = *(const f32x2*)(ODN + (size_t)m * 1024 + h * 128 + 2 * lane);
        const float ss = wave_sum(o.x * o.x + o.y * o.y), r = 1.0f / sqrtf(ss * (1.0f / 128.0f) + LN_EPS);
        const unsigned zz = *(const unsigned*)(PROJ + (size_t)m * PLD + 3072 + h * 128 + 2 * lane);
        *(unsigned*)(MIX + (size_t)m * DM + h * 128 + 2 * lane) = pk2(o.x * r * g2.x * silu_f(lo_bf(zz)), o.y * r * g2.y * silu_f(hi_bf(zz))); }
}

__device__ __forceinline__ void sincos_cw(float x, float& s, float& c) {
    const float kf = rintf(x * 0.6366197723675814f); const int k = (int)kf;
    float r = fmaf(kf, -1.5703125f, x); r = fmaf(kf, -4.837512969970703125e-4f, r); r = fmaf(kf, -7.54978995489188216e-8f, r);
    const float r2 = r * r;
    const float sp = r + r * r2 * (-1.6666654611e-1f + r2 * (8.3321608736e-3f + r2 * (-1.9515295891e-4f)));
    const float cp = 1.0f - 0.5f * r2 + r2 * r2 * (4.166664568298827e-2f + r2 * (-1.388731625493765e-3f + r2 * 2.443315711809948e-5f));
    const int qd = k & 3;
    s = (qd == 0) ? sp : (qd == 1) ? cp : (qd == 2) ? -sp : -cp;
    c = (qd == 0) ? cp : (qd == 1) ? -sp : (qd == 2) ? -cp : sp;
}
struct S5Par { float abr, abi; float bbr[16], bbi[16]; };
__device__ __forceinline__ void s5_params(S5Par& P, const float* a_re, const float* a_im, const float* b_re, const float* b_im, const float* log_dt, int g, int lane) {
    const float are = a_re[g * 64 + lane], aim = a_im[g * 64 + lane], dt = expf(log_dt[g]);
    const float er = expf(are * dt); float sn, cs; sincos_cw(aim * dt, sn, cs);
    P.abr = er * cs; P.abi = er * sn;
    const float nr = P.abr - 1.0f, ni = P.abi, den = 1.0f / (are * are + aim * aim);
    const float cr = (nr * are + ni * aim) * den, ci = (ni * are - nr * aim) * den;
    const float* br = b_re + (size_t)(g * 64 + lane) * 16; const float* bi = b_im + (size_t)(g * 64 + lane) * 16;
#pragma unroll
    for (int c4 = 0; c4 < 4; ++c4) { const f32x4 r4 = *(const f32x4*)(br + 4 * c4), i4 = *(const f32x4*)(bi + 4 * c4);
#pragma unroll
        for (int j = 0; j < 4; ++j) { P.bbr[4 * c4 + j] = cr * r4[j] - ci * i4[j]; P.bbi[4 * c4 + j] = cr * i4[j] + ci * r4[j]; } }
}
#define S5_STEP(ubp_) do { const v4u ua = *(const LAS v4u*)(ubp_), ub2 = *(const LAS v4u*)((ubp_) + 16); float uu[16]; \
        uu[0] = lo_bf(ua.x); uu[1] = hi_bf(ua.x); uu[2] = lo_bf(ua.y); uu[3] = hi_bf(ua.y); uu[4] = lo_bf(ua.z); uu[5] = hi_bf(ua.z); uu[6] = lo_bf(ua.w); uu[7] = hi_bf(ua.w); \
        uu[8] = lo_bf(ub2.x); uu[9] = hi_bf(ub2.x); uu[10] = lo_bf(ub2.y); uu[11] = hi_bf(ub2.y); uu[12] = lo_bf(ub2.z); uu[13] = hi_bf(ub2.z); uu[14] = lo_bf(ub2.w); uu[15] = hi_bf(ub2.w); \
        float br_ = 0.f, bi_ = 0.f; _Pragma("unroll") for (int c = 0; c < 16; ++c) { br_ += P.bbr[c] * uu[c]; bi_ += P.bbi[c] * uu[c]; } \
        const float nr_ = P.abr * sr - P.abi * si + br_, ni_ = P.abr * si + P.abi * sr + bi_; sr = nr_; si = ni_; } while (0)
__device__ __forceinline__ void s5_pass1(LAS unsigned char* lds, const bf16* PROJ, const float* a_re, const float* a_im, const float* b_re, const float* b_im, const float* log_dt,
                                         float* S5END, int first, int nblk) {
    int tid_ = threadIdx.x; asm volatile("" : "+v"(tid_)); const int tid = tid_, lane = tid & 63, w = __builtin_amdgcn_readfirstlane(tid >> 6);
    LAS unsigned char* ub = lds + w * 2048;
    for (int bi = (int)blockIdx.x - first; bi < 256; bi += nblk) {
        const int b = bi >> 6, g = bi & 63;
        S5Par P; s5_params(P, a_re, a_im, b_re, b_im, log_dt, g, lane);
        float sr = 0.f, si = 0.f;
        for (int sb = 0; sb < 4; ++sb) {
            const bf16* up = PROJ + (size_t)(b * SEQ + w * 256 + sb * 64 + lane) * PLD + 4096 + 16 * g;
            const v4u u0 = *(const v4u*)up, u1 = *(const v4u*)(up + 8);
            LDS_WAIT();
            *(LAS v4u*)(ub + lane * 32) = u0; *(LAS v4u*)(ub + lane * 32 + 16) = u1;
            LDS_WAIT();
            for (int tt = 0; tt < 64; ++tt) { S5_STEP(ub + tt * 32); }
        }
        *(f32x2*)(S5END + ((size_t)(bi * 8 + w) * 64 + lane) * 2) = (f32x2){sr, si};
    }
}
__device__ __forceinline__ float gelu_tanh_f(float y) { const float a = 0.7978845608028654f * (y + 0.044715f * y * y * y); const float t = 1.0f - 2.0f / (__expf(2.0f * a) + 1.0f); return 0.5f * y * (1.0f + t); }
__device__ __forceinline__ void s5_pass2(LAS unsigned char* lds, const bf16* PROJ, const float* a_re, const float* a_im, const float* b_re, const float* b_im, const float* c_re, const float* c_im,
                                         const float* dvec, const float* log_dt, const float* S5END, bf16* YPRE, int first, int nblk) {
    int tid_ = threadIdx.x; asm volatile("" : "+v"(tid_)); const int tid = tid_, lane = tid & 63, w = __builtin_amdgcn_readfirstlane(tid >> 6);
    LAS float* CL = (LAS float*)lds;
    LAS unsigned char* ub = lds + 8192 + w * 2048;
    LAS f32x2* SB = (LAS f32x2*)(lds + 24576 + w * 8320);
    for (int bi = (int)blockIdx.x - first; bi < 256; bi += nblk) {
        const int b = bi >> 6, g = bi & 63;
        __syncthreads();
        for (int e = tid; e < 1024; e += 512) { const int p = e >> 4, c = e & 15; CL[e * 2] = c_re[(size_t)(g * 16 + c) * 64 + p]; CL[e * 2 + 1] = c_im[(size_t)(g * 16 + c) * 64 + p]; }
        __syncthreads();
        S5Par P; s5_params(P, a_re, a_im, b_re, b_im, log_dt, g, lane);
        float sr = 0.f, si = 0.f;
        { float pr = P.abr, pi = P.abi;
#pragma unroll
          for (int k = 0; k < 8; ++k) { const float t = pr * pr - pi * pi; pi = 2.0f * pr * pi; pr = t; }
          for (int i = 0; i < w; ++i) { const f32x2 e = *(const f32x2*)(S5END + ((size_t)(bi * 8 + i) * 64 + lane) * 2);
              const float nr = sr * pr - si * pi + e.x, ni = sr * pi + si * pr + e.y; sr = nr; si = ni; } }
        const int tq = lane >> 2, cg = lane & 3;
        const f32x4 d4 = *(const f32x4*)(dvec + g * 16 + 4 * cg);
        for (int sb = 0; sb < 4; ++sb) {
            const int trow = b * SEQ + w * 256 + sb * 64;
            { const bf16* up = PROJ + (size_t)(trow + lane) * PLD + 4096 + 16 * g; const v4u u0 = *(const v4u*)up, u1 = *(const v4u*)(up + 8);
              LDS_WAIT(); *(LAS v4u*)(ub + lane * 32) = u0; *(LAS v4u*)(ub + lane * 32 + 16) = u1; LDS_WAIT(); }
            for (int blk = 0; blk < 4; ++blk) {
#pragma unroll 4
                for (int tt = 0; tt < 16; ++tt) { S5_STEP(ub + (blk * 16 + tt) * 32); SB[tt * 65 + lane] = (f32x2){sr, si}; }
                LDS_WAIT();
                float y0 = 0.f, y1 = 0.f, y2 = 0.f, y3 = 0.f;
#pragma unroll 8
                for (int p = 0; p < 64; ++p) { const f32x2 s = SB[tq * 65 + p]; const f32x4 c0 = *(const LAS f32x4*)(CL + p * 32 + 8 * cg), c1 = *(const LAS f32x4*)(CL + p * 32 + 8 * cg + 4);
                    y0 += c0.x * s.x - c0.y * s.y; y1 += c0.z * s.x - c0.w * s.y; y2 += c1.x * s.x - c1.y * s.y; y3 += c1.z * s.x - c1.w * s.y; }
                const v2u uw = *(const LAS v2u*)(ub + (blk * 16 + tq) * 32 + 8 * cg);
                y0 += d4.x * lo_bf(uw.x); y1 += d4.y * hi_bf(uw.x); y2 += d4.z * lo_bf(uw.y); y3 += d4.w * hi_bf(uw.y);
                v2u o; o.x = pk2(gelu_tanh_f(y0), gelu_tanh_f(y1)); o.y = pk2(gelu_tanh_f(y2), gelu_tanh_f(y3));
                *(v2u*)(YPRE + (size_t)(trow + blk * 16 + tq) * 1024 + 16 * g + 4 * cg) = o;
                LDS_WAIT();
            }
        }
    }
}

#ifndef PH_MASK
#define PH_MASK 0xffffffffu
#endif
#define EN(k) (((PH_MASK) >> (k)) & 1u)
__global__ void __launch_bounds__(512, 2) fwd(Args args) {
    extern __shared__ __attribute__((aligned(16))) unsigned char lds_raw[];
    LAS unsigned char* lds = (LAS unsigned char*)lds_raw;
    const int tid = threadIdx.x, G = gridDim.x;
    unsigned char* ws = args.ws;
    const int lo = args.ph_lo, hi = args.ph_hi;
    volatile LAS unsigned* MISC = (volatile LAS unsigned*)(lds + LDS_MISC);
    if (tid < 8) MISC[tid] = 0u;
    __syncthreads();
    XcdBarrier bar; bar.bar = (unsigned*)(ws + WS_CTL) + CW_BAR; bar.x = 0; bar.st = nullptr;
    if (hi - lo > 1) bar = xcd_barrier_post((unsigned*)(ws + WS_CTL) + CW_BAR, MISC);
#define IN(k) (lo <= (k) && (k) < hi)
#define SEAM(k) do { if ((k) + 1 < hi) xcd_barrier(bar); } while (0)
    float* X = (float*)(ws + WS_X); bf16* H = (bf16*)(ws + WS_H); bf16* PROJ = (bf16*)(ws + WS_PROJ); bf16* MIX = (bf16*)(ws + WS_MIX);
    float* Y = (float*)(ws + WS_Y); bf16* HID = (bf16*)(ws + WS_HID); float* MOD = (float*)(ws + WS_MOD); bf16* YPRE = (bf16*)(ws + WS_YPRE); float* ODN = (float*)(ws + WS_ODN);
    bf16* CHU = (bf16*)(ws + WS_CHU); bf16* CHW = (bf16*)(ws + WS_CHW); bf16* CHQD = (bf16*)(ws + WS_CHQD); bf16* CHKT = (bf16*)(ws + WS_CHKT); bf16* CHA = (bf16*)(ws + WS_CHA);
    float* CHGL = (float*)(ws + WS_CHGL); float* S5END = (float*)(ws + WS_S5END);

    if (IN(0)) { if (EN(0)) p0a_phase(lds, args, G); SEAM(0); }
    if (IN(1)) { if (EN(1)) modulate_phase(args.in[0], MOD, 0, 2048, H, G); SEAM(1); }

#pragma nounroll
    for (int i = 0; i < 4; ++i) {
        const int j = i >> 1; const bool odd = (i & 1) != 0;
        int p = 2 + j * 16 + (odd ? 9 : 0);
        const float* MODl = MOD + (size_t)i * 4 * 12288;
        const float* Xin = (i == 0) ? args.in[0] : X;
        if (IN(p)) {
            pg8::Gemm g{H, (const bf16*)(ws + WS_WIN + i * WIN_STRIDE), MTOK, odd ? NIN_O : NIN_E, DM}; pg8::StaticOrder S; S.init(MTOK, g.N, G, (int)blockIdx.x);
            pg8::EpiB16 E{PROJ, PLD};
            if (EN(2)) pg8::gemm_phase<pg8::EpiB16, pg8::StaticOrder, true, true>(lds, g, S, E);
            SEAM(p);
        }
        ++p;
        if (!odd) {
            const float* a_re = args.in[17] + (size_t)j * 4096; const float* a_im = args.in[18] + (size_t)j * 4096;
            const float* b_re = args.in[19] + (size_t)j * 65536; const float* b_im = args.in[20] + (size_t)j * 65536;
            const float* c_re = args.in[21] + (size_t)j * 65536; const float* c_im = args.in[22] + (size_t)j * 65536;
            const float* s5d = args.in[23] + (size_t)j * 1024; const float* log_dt = args.in[24] + (size_t)j * 64;
            if (IN(p)) {
                if (EN(3)) dn_prep_phase(lds, PROJ, args.in[13] + (size_t)j * 4 * 3072, args.in[14] + j * 8, args.in[15] + j * 8, CHU, CHW, CHQD, CHKT, CHA, CHGL, G);
                if (EN(4)) s5_pass1(lds, PROJ, a_re, a_im, b_re, b_im, log_dt, S5END, 0, G);
                SEAM(p);
            }
            ++p;
            if (IN(p)) {
                const int first = (G >= 256) ? 128 : 0;
                if (EN(5)) if ((int)blockIdx.x < 128 || first == 0) dn_scan_phase(lds, CHU, CHW, CHQD, CHKT, CHA, CHGL, ODN, (first == 0) ? G : 128);
                if (EN(6)) if ((int)blockIdx.x >= first) s5_pass2(lds, PROJ, a_re, a_im, b_re, b_im, c_re, c_im, s5d, log_dt, S5END, YPRE, first, G - first);
                SEAM(p);
            }
            ++p;
            if (IN(p)) {
                pg8::Gemm g{YPRE, (const bf16*)(ws + WS_WGLU + j * WGLU_STRIDE), MTOK, 1024, 1024}; pg8::StaticOrder S; S.init(MTOK, 1024, G, (int)blockIdx.x);
                pg8::EpiGlu E{YPRE, 1024, MIX, DM, 1024};
                if (EN(7)) pg8::gemm_phase<pg8::EpiGlu, pg8::StaticOrder, true, true>(lds, g, S, E);
                if (EN(8)) dn_gate_phase(ODN, PROJ, args.in[16] + j * 128, MIX, G);
                SEAM(p);
            }
            ++p;
        } else {
            if (IN(p)) {
                if (EN(9)) shortconv_phase(PROJ, args.in[28] + (size_t)j * 3 * 1024, MIX, G);
                const float lambda_init = (i == 1) ? 0.35550906759277307f : 0.55605818415556050f;
                if (EN(10)) attn_phase(lds, PROJ, MIX, args.in[29] + j * 128, args.in[30] + j * 128, args.in[31] + j * 128, args.in[32] + j * 128, args.in[33] + j * 256, lambda_init, G);
                SEAM(p);
            }
            ++p;
        }
        if (IN(p)) {
            pg8::Gemm g{MIX, (const bf16*)(ws + WS_WOUT + i * WOUT_STRIDE), MTOK, DM, DM}; pg8::StaticOrder S; S.init(MTOK, DM, G, (int)blockIdx.x);
            pg8::EpiF32o E{Y, DM};
            if (EN(11)) pg8::gemm_phase<pg8::EpiF32o, pg8::StaticOrder, true, true>(lds, g, S, E);
            SEAM(p);
        }
        ++p;
        if (IN(p)) { if (EN(12)) ln_phase(Xin, Y, X, H, MODl + 4096, args.in[4] + i * DM, args.in[5] + i * DM, MODl, 6144, 8192, G); SEAM(p); }
        ++p;
        if (IN(p)) {
            pg8::Gemm g{H, (const bf16*)(ws + WS_WGU + i * WGU_STRIDE), MTOK, 2 * DFF, DM}; pg8::StaticOrder S; S.init(MTOK, 2 * DFF, G, (int)blockIdx.x);
            pg8::EpiSwiGlu E{HID, DFF};
            if (EN(13)) pg8::gemm_phase<pg8::EpiSwiGlu, pg8::StaticOrder, true, true>(lds, g, S, E);
            SEAM(p);
        }
        ++p;
        if (IN(p)) {
            pg8::Gemm g{HID, (const bf16*)(ws + WS_WDN + i * WDN_STRIDE), MTOK, DM, DFF}; pg8::StaticOrder S; S.init(MTOK, DM, G, (int)blockIdx.x);
            pg8::EpiF32o E{Y, DM};
            if (EN(14)) pg8::gemm_phase<pg8::EpiF32o, pg8::StaticOrder, true, true>(lds, g, S, E);
            SEAM(p);
        }
        ++p;
        if (IN(p)) {
            if (EN(15)) { if (i < 3) ln_phase(X, Y, X, H, MODl + 10240, args.in[6] + i * DM, args.in[7] + i * DM, MODl + 4 * 12288, 0, 2048, G);
            else ln_phase(X, Y, args.out, H, MODl + 10240, args.in[6] + i * DM, args.in[7] + i * DM, nullptr, 0, 0, G); }
            SEAM(p);
        }
        ++p;
    }
#undef IN
#undef SEAM
}

extern "C" void kernel_launch(void* const* d_in, const int* in_sizes, int n_in, void* d_out, int out_size, void* d_ws, size_t ws_size, hipStream_t stream) {
    static int grid = 0;
    if (grid == 0) {
        if (n_in != 34 || in_sizes[0] != MTOK * DM || out_size != MTOK * DM || ws_size < WS_END) {
            fprintf(stderr, "kernel_launch: unexpected shapes (n_in %d, in0 %d, out %d, ws %zu < %zu); nothing launched\n", n_in, n_in > 0 ? in_sizes[0] : -1, out_size, ws_size, (size_t)WS_END); grid = -1; return; }
        int dev = 0, cus = 0;
        if (hipGetDevice(&dev) != hipSuccess || hipDeviceGetAttribute(&cus, hipDeviceAttributeMultiprocessorCount, dev) != hipSuccess) { fprintf(stderr, "kernel_launch: device query failed\n"); grid = -1; return; }
        if (hipFuncSetAttribute((const void*)fwd, hipFuncAttributeMaxDynamicSharedMemorySize, LDS_BYTES) != hipSuccess) { fprintf(stderr, "kernel_launch: hipFuncSetAttribute failed\n"); grid = -1; return; }
        int per_cu = 0;
        if (hipOccupancyMaxActiveBlocksPerMultiprocessor(&per_cu, (const void*)fwd, 512, LDS_BYTES) != hipSuccess || per_cu < 1) fprintf(stderr, "kernel_launch: note: occupancy query reports %d\n", per_cu);
        (void)hipGetLastError();
        grid = cus;
    }
    if (grid < 0) return;
    if (hipMemsetAsync((char*)d_ws + WS_CTL, 0, CTL_ZERO_BYTES, stream) != hipSuccess) { fprintf(stderr, "kernel_launch: memset failed\n"); return; }
    Args a{};
    for (int i = 0; i < 34; ++i) a.in[i] = (const float*)d_in[i];
    a.out = (float*)d_out; a.ws = (unsigned char*)d_ws;
#if MK_MULTI
    for (int p = 0; p < NPH; ++p) { a.ph_lo = p; a.ph_hi = p + 1; hipLaunchKernelGGL(fwd, dim3(grid), dim3(512), LDS_BYTES, stream, a); }
#else
    a.ph_lo = 0; a.ph_hi = NPH; hipLaunchKernelGGL(fwd, dim3(grid), dim3(512), LDS_BYTES, stream, a);
#endif
    const hipError_t le = hipPeekAtLastError();
    if (le != hipSuccess) fprintf(stderr, "kernel_launch: launch failed: %s\n", hipGetErrorName(le));
}
```

```cpp
#include <hip/hip_runtime.h>
#include <cstdio>
#include <cstdint>
#ifndef MK_MULTI
#define MK_MULTI 0
#endif
namespace pg8 {
#define PG8_LAS __attribute__((address_space(3)))
typedef unsigned short bf16_t;
typedef short bf16x8 __attribute__((ext_vector_type(8)));
typedef float f32x4 __attribute__((ext_vector_type(4)));
typedef unsigned u32x4 __attribute__((ext_vector_type(4)));
constexpr int BM = 256, BK = 64, HALF = 128, HTB = HALF * BK * 2  , STAGE_BYTES = 8 * HTB, NXCD = 8, WGM = 8;

__host__ __device__ __forceinline__ int lds_byte(int r, int c) { const int st = (r >> 4) * 2 + (c >> 5), rr = r & 15, cc = c & 31, ob = rr * 64 + cc * 2; return st * 1024 + (ob ^ (((ob >> 9) & 1) << 5)); }
__host__ __device__ __forceinline__ void stage_rc(int b, int& R, int& C) { const int st = b / 1024, sb = b % 1024, swz = sb ^ (((sb >> 9) & 1) << 5); R = (st >> 1) * 16 + swz / 64; C = (st & 1) * 32 + (swz % 64) / 2; }
__host__ __device__ __forceinline__ int perm32(int rho) { const int n = rho >> 4, i = rho & 15; return 8 * (i >> 2) + 4 * n + (i & 3); }

struct Unit { int pm, pn; };
struct Gemm { const bf16_t* A; const bf16_t* Bt; int M, N, K; };

struct StaticOrder {
    int nM, nN, nwg, G, c;
    __host__ __device__ void init(int M, int N, int G_, int c_) { nM = M / BM; nN = N / BM; nwg = nM * nN; G = G_; c = c_; }
    __host__ __device__ bool next(int i, Unit& u) const {
        const long L = (long)i * G + c; if (L >= nwg) return false;
        int wgid = (int)L; { const int q = nwg / NXCD, r = nwg % NXCD, xcd = wgid % NXCD, off = wgid / NXCD; wgid = (xcd < r ? xcd * (q + 1) : r * (q + 1) + (xcd - r) * q) + off; }
        const int nig = WGM * nN, gid = wgid / nig, fm = gid * WGM, gsz = (nM - fm) < WGM ? (nM - fm) : WGM;
        u.pm = fm + ((wgid % nig) % gsz); u.pn = (wgid % nig) / gsz; return true;
    }
    __device__ __forceinline__ void a_ready(const Unit&) const {}
    __device__ __forceinline__ void done(const Unit&) const {}
};

__device__ __forceinline__ unsigned cvt_pk_bf16(float lo, float hi) { unsigned r; asm volatile("v_cvt_pk_bf16_f32 %0, %1, %2" : "=v"(r) : "v"(lo), "v"(hi)); return r; }
__device__ __forceinline__ float ep_sigmoid(float x) { return __builtin_amdgcn_rcpf(1.0f + __expf(-x)); }
__device__ __forceinline__ float ep_lo(unsigned w) { return __uint_as_float(w << 16); }
__device__ __forceinline__ float ep_hi(unsigned w) { return __uint_as_float(w & 0xffff0000u); }
struct EpiB16 {
    static constexpr bool PERM = true, AFTER_DRAIN = false;
    bf16_t* O; int ldc;
    __device__ __forceinline__ void operator()(const f32x4 (&acc)[2][2][4][2], const Unit& u, int wr, int wc, int fr, int fq) const {
        const int row0 = u.pm * BM + wr * 64 + fr, col0 = u.pn * BM + wc * 32 + 8 * fq;
#pragma unroll
        for (int ai = 0; ai < 2; ++ai)
#pragma unroll
            for (int m = 0; m < 4; ++m) { bf16_t* rowp = O + (size_t)(row0 + ai * HALF + m * 16) * ldc + col0;
#pragma unroll
                for (int bj = 0; bj < 2; ++bj) { const f32x4 v0 = acc[ai][bj][m][0], v1 = acc[ai][bj][m][1];
                    u32x4 w; w.x = cvt_pk_bf16(v0[0], v0[1]); w.y = cvt_pk_bf16(v0[2], v0[3]); w.z = cvt_pk_bf16(v1[0], v1[1]); w.w = cvt_pk_bf16(v1[2], v1[3]);
                    *(u32x4*)(rowp + bj * HALF) = w; } }
    }
};
struct EpiF32o {
    static constexpr bool PERM = false, AFTER_DRAIN = false;
    float* C; int ldc;
    __device__ __forceinline__ void operator()(const f32x4 (&acc)[2][2][4][2], const Unit& u, int wr, int wc, int fr, int fq) const {
        const int row0 = u.pm * BM + wr * 64 + fr, col0 = u.pn * BM + wc * 32 + 4 * fq;
#pragma unroll
        for (int ai = 0; ai < 2; ++ai)
#pragma unroll
            for (int m = 0; m < 4; ++m) { float* rowp = C + (size_t)(row0 + ai * HALF + m * 16) * ldc + col0;
#pragma unroll
                for (int bj = 0; bj < 2; ++bj)
#pragma unroll
                    for (int n = 0; n < 2; ++n) *(f32x4*)(rowp + bj * HALF + n * 16) = acc[ai][bj][m][n]; }
    }
};
struct EpiSwiGlu {
    static constexpr bool PERM = true, AFTER_DRAIN = false;
    bf16_t* O; int ldc;
    __device__ __forceinline__ void operator()(const f32x4 (&acc)[2][2][4][2], const Unit& u, int wr, int wc, int fr, int fq) const {
        const int row0 = u.pm * BM + wr * 64 + fr, col0 = u.pn * HALF + wc * 32 + 8 * fq;
#pragma unroll
        for (int ai = 0; ai < 2; ++ai)
#pragma unroll
            for (int m = 0; m < 4; ++m) { bf16_t* rowp = O + (size_t)(row0 + ai * HALF + m * 16) * ldc + col0;
                float h[8];
#pragma unroll
                for (int n = 0; n < 2; ++n)
#pragma unroll
                    for (int j = 0; j < 4; ++j) { const float g = acc[ai][0][m][n][j], up = acc[ai][1][m][n][j]; h[4 * n + j] = g * ep_sigmoid(g) * up; }
                u32x4 w; w.x = cvt_pk_bf16(h[0], h[1]); w.y = cvt_pk_bf16(h[2], h[3]); w.z = cvt_pk_bf16(h[4], h[5]); w.w = cvt_pk_bf16(h[6], h[7]);
                *(u32x4*)rowp = w; }
    }
};
struct EpiGlu {
    static constexpr bool PERM = true, AFTER_DRAIN = false;
    const bf16_t* Y; int ldy; bf16_t* O; int ldo; int ocol0;
    __device__ __forceinline__ void operator()(const f32x4 (&acc)[2][2][4][2], const Unit& u, int wr, int wc, int fr, int fq) const {
        const int row0 = u.pm * BM + wr * 64 + fr, col0 = u.pn * BM + wc * 32 + 8 * fq;
#pragma unroll
        for (int ai = 0; ai < 2; ++ai)
#pragma unroll
            for (int m = 0; m < 4; ++m) { const size_t row = (size_t)(row0 + ai * HALF + m * 16);
#pragma unroll
                for (int bj = 0; bj < 2; ++bj) { const f32x4 v0 = acc[ai][bj][m][0], v1 = acc[ai][bj][m][1];
                    const u32x4 yv = *(const u32x4*)(Y + row * ldy + col0 + bj * HALF);
                    u32x4 w;
                    w.x = cvt_pk_bf16(ep_lo(yv.x) * ep_sigmoid(v0[0]), ep_hi(yv.x) * ep_sigmoid(v0[1]));
                    w.y = cvt_pk_bf16(ep_lo(yv.y) * ep_sigmoid(v0[2]), ep_hi(yv.y) * ep_sigmoid(v0[3]));
                    w.z = cvt_pk_bf16(ep_lo(yv.z) * ep_sigmoid(v1[0]), ep_hi(yv.z) * ep_sigmoid(v1[1]));
                    w.w = cvt_pk_bf16(ep_lo(yv.w) * ep_sigmoid(v1[2]), ep_hi(yv.w) * ep_sigmoid(v1[3]));
                    *(u32x4*)(O + row * ldo + ocol0 + col0 + bj * HALF) = w; } }
    }
};

template <class Epi, class Sched, bool ALIGN_EPI = false, bool SP2 = false>
__device__ __forceinline__ void gemm_phase(PG8_LAS unsigned char* lds, const Gemm g, const Sched& S, const Epi& E) {
    int tid_ = threadIdx.x; asm volatile("" : "+v"(tid_));   const int tid = tid_, wid = __builtin_amdgcn_readfirstlane(tid >> 6), lane = tid & 63, wr = wid >> 2, wc = wid & 3, fr = lane & 15, fq = lane >> 4;
    const int K = g.K, nt = K / BK;
    unsigned voffA[2], voffB[2];
#pragma unroll
    for (int i = 0; i < 2; ++i) { int R, C; stage_rc(tid * 16 + i * 8192, R, C); const int Rb = Epi::PERM ? ((R & ~31) + perm32(R & 31)) : R;
        voffA[i] = (unsigned)(R * K + C) * 2u; voffB[i] = (unsigned)(Rb * K + C) * 2u; }
    const size_t kstep = (size_t)(BK * 2);
    const size_t hstep = (size_t)HALF * K * 2;
    const size_t tstep = 2 * hstep;
    const unsigned ldsw = (unsigned)wid * 1024u;
    const int aoff = lds_byte(wr * 64 + fr, fq * 8), boff = lds_byte(wc * 32 + fr, fq * 8);
#define PG8_SA(b, h) (((b) * 2 + (h)) * HTB)
#define PG8_SB(b, h) ((4 + (b) * 2 + (h)) * HTB)
#define PG8_STAGE(bufoff, gbase, voff) do { _Pragma("unroll") for (int _i = 0; _i < 2; ++_i) \
        __builtin_amdgcn_global_load_lds((const unsigned*)((const char*)(gbase) + (voff)[_i]), (PG8_LAS unsigned*)(lds + (bufoff) + ldsw + _i * 8192), 16, 0, 0); } while (0)
#define PG8_LDA(dst, b, h) do { _Pragma("unroll") for (int m = 0; m < 4; ++m) _Pragma("unroll") for (int k = 0; k < 2; ++k) dst[m][k] = *(const PG8_LAS bf16x8*)(lds + PG8_SA(b, h) + aoff + m * 2048 + k * 1024); } while (0)
#define PG8_LDB(dst, b, h) do { _Pragma("unroll") for (int n = 0; n < 2; ++n) _Pragma("unroll") for (int k = 0; k < 2; ++k) dst[n][k] = *(const PG8_LAS bf16x8*)(lds + PG8_SB(b, h) + boff + n * 2048 + k * 1024); } while (0)
#define PG8_MMA(ai, bj, At, Bt) do { __builtin_amdgcn_s_setprio(1); _Pragma("unroll") for (int m = 0; m < 4; ++m) _Pragma("unroll") for (int n = 0; n < 2; ++n) _Pragma("unroll") for (int k = 0; k < 2; ++k) \
        acc[ai][bj][m][n] = __builtin_amdgcn_mfma_f32_16x16x32_bf16(Bt[n][k], At[m][k], acc[ai][bj][m][n], 0, 0, 0); __builtin_amdgcn_s_setprio(0); } while (0)
#define PG8_WAIT_V(n) asm volatile("s_waitcnt vmcnt(" #n ")" ::: "memory")
#define PG8_WAIT_L(n) asm volatile("s_waitcnt lgkmcnt(" #n ")" ::: "memory")
#define PG8_BAR __builtin_amdgcn_s_barrier()
#define PG8_SCHED __builtin_amdgcn_sched_barrier(0)
    Unit cur, nxt; int ui = 0;
    if (!S.next(0, cur)) return;
    f32x4 acc[2][2][4][2];
#pragma unroll
    for (int a = 0; a < 2; ++a)
#pragma unroll
        for (int b = 0; b < 2; ++b)
#pragma unroll
            for (int m = 0; m < 4; ++m)
#pragma unroll
                for (int n = 0; n < 2; ++n) acc[a][b][m][n] = (f32x4){0.f, 0.f, 0.f, 0.f};
    bf16x8 At[4][2], B0[2][2], B1[2][2];
    const char* cA = (const char*)g.A + (size_t)cur.pm * tstep; const char* cB = (const char*)g.Bt + (size_t)cur.pn * tstep;
    S.a_ready(cur);
    if constexpr (SP2) {
        PG8_STAGE(PG8_SB(0, 0), cB, voffB); PG8_STAGE(PG8_SB(0, 1), cB + hstep, voffB); PG8_STAGE(PG8_SA(0, 0), cA, voffA); PG8_STAGE(PG8_SA(0, 1), cA + hstep, voffA);
        if (wr == 1) PG8_BAR;
        PG8_WAIT_V(2); PG8_BAR;
        PG8_STAGE(PG8_SB(1, 0), cB + kstep, voffB); PG8_STAGE(PG8_SA(1, 0), cA + kstep, voffA); PG8_STAGE(PG8_SB(1, 1), cB + hstep + kstep, voffB);
        PG8_WAIT_V(6); PG8_BAR;
    } else {
        PG8_STAGE(PG8_SB(0, 0), cB, voffB); PG8_STAGE(PG8_SA(0, 0), cA, voffA); PG8_STAGE(PG8_SB(0, 1), cB + hstep, voffB); PG8_STAGE(PG8_SA(0, 1), cA + hstep, voffA);
        if (wr == 1) PG8_BAR;
        PG8_WAIT_V(4); PG8_BAR;
        PG8_STAGE(PG8_SB(1, 0), cB + kstep, voffB); PG8_STAGE(PG8_SA(1, 0), cA + kstep, voffA); PG8_STAGE(PG8_SB(1, 1), cB + hstep + kstep, voffB);
        PG8_WAIT_V(6); PG8_BAR;
    }
    for (;;) {
        const bool has_next = S.next(ui + 1, nxt);
        const char* nA = has_next ? (const char*)g.A + (size_t)nxt.pm * tstep : cA; const char* nB = has_next ? (const char*)g.Bt + (size_t)nxt.pn * tstep : cB;
        for (int t = 0; t < nt; t += 2) {
            const bool last = (t == nt - 2);
            const char* a1 = cA + (size_t)(t + 1) * kstep;
            const char* a2 = last ? nA : cA + (size_t)(t + 2) * kstep; const char* b2 = last ? nB : cB + (size_t)(t + 2) * kstep;
            const char* a3 = a2 + kstep; const char* b3 = b2 + kstep;
            if (last && has_next) S.a_ready(nxt);
            if constexpr (SP2) {
            PG8_LDB(B0, 0, 0); PG8_LDB(B1, 0, 1); PG8_SCHED; PG8_LDA(At, 0, 0); PG8_STAGE(PG8_SA(1, 1), a1 + hstep, voffA);
            PG8_WAIT_V(8); PG8_WAIT_L(0); PG8_BAR; PG8_MMA(0, 0, At, B0); PG8_MMA(0, 1, At, B1); PG8_BAR; PG8_SCHED;
            PG8_LDA(At, 0, 1); PG8_STAGE(PG8_SB(0, 0), b2, voffB); PG8_STAGE(PG8_SB(0, 1), b2 + hstep, voffB); PG8_STAGE(PG8_SA(0, 0), a2, voffA);
            PG8_WAIT_V(8); PG8_WAIT_L(0); PG8_BAR; PG8_MMA(1, 0, At, B0); PG8_MMA(1, 1, At, B1); PG8_BAR; PG8_SCHED;
            PG8_LDB(B0, 1, 0); PG8_LDB(B1, 1, 1); PG8_SCHED; PG8_LDA(At, 1, 0); PG8_STAGE(PG8_SA(0, 1), a2 + hstep, voffA);
            PG8_WAIT_V(8); PG8_WAIT_L(0); PG8_BAR; PG8_MMA(0, 0, At, B0); PG8_MMA(0, 1, At, B1); PG8_BAR; PG8_SCHED;
            PG8_LDA(At, 1, 1); PG8_STAGE(PG8_SB(1, 0), b3, voffB); PG8_STAGE(PG8_SB(1, 1), b3 + hstep, voffB); PG8_STAGE(PG8_SA(1, 0), a3, voffA);
            PG8_WAIT_V(8); PG8_WAIT_L(0); PG8_BAR; PG8_MMA(1, 0, At, B0); PG8_MMA(1, 1, At, B1); PG8_BAR; PG8_SCHED;
            } else {
            PG8_LDB(B0, 0, 0); PG8_SCHED; PG8_LDA(At, 0, 0); PG8_STAGE(PG8_SA(1, 1), a1 + hstep, voffA);
            PG8_WAIT_L(8); PG8_BAR; PG8_WAIT_L(0); PG8_MMA(0, 0, At, B0); PG8_BAR; PG8_SCHED;
            PG8_LDB(B1, 0, 1); PG8_STAGE(PG8_SB(0, 0), b2, voffB);
            PG8_BAR; PG8_WAIT_L(0); PG8_MMA(0, 1, At, B1); PG8_BAR;
            PG8_LDA(At, 0, 1); PG8_STAGE(PG8_SA(0, 0), a2, voffA);
            PG8_BAR; PG8_WAIT_L(0); PG8_MMA(1, 0, At, B0); PG8_BAR; PG8_SCHED;
            PG8_STAGE(PG8_SB(0, 1), b2 + hstep, voffB);
            PG8_WAIT_V(6); PG8_BAR; PG8_MMA(1, 1, At, B1); PG8_BAR;
            PG8_LDB(B0, 1, 0); PG8_SCHED; PG8_LDA(At, 1, 0); PG8_STAGE(PG8_SA(0, 1), a2 + hstep, voffA);
            PG8_WAIT_L(8); PG8_BAR; PG8_WAIT_L(0); PG8_MMA(0, 0, At, B0); PG8_BAR; PG8_SCHED;
            PG8_LDB(B1, 1, 1); PG8_STAGE(PG8_SB(1, 0), b3, voffB);
            PG8_BAR; PG8_WAIT_L(0); PG8_MMA(0, 1, At, B1); PG8_BAR;
            PG8_LDA(At, 1, 1); PG8_STAGE(PG8_SA(1, 0), a3, voffA);
            PG8_BAR; PG8_WAIT_L(0); PG8_MMA(1, 0, At, B0); PG8_BAR; PG8_SCHED;
            PG8_STAGE(PG8_SB(1, 1), b3 + hstep, voffB);
            PG8_WAIT_V(6); PG8_BAR; PG8_MMA(1, 1, At, B1); PG8_BAR;
            }
        }
        if constexpr (ALIGN_EPI) { if (wr == 0) PG8_BAR; }
        if constexpr (!Epi::AFTER_DRAIN) { E(acc, cur, wr, wc, fr, fq); S.done(cur); }
        if (!has_next) break;
#pragma unroll
        for (int a = 0; a < 2; ++a)
#pragma unroll
            for (int b = 0; b < 2; ++b)
#pragma unroll
                for (int m = 0; m < 4; ++m)
#pragma unroll
                    for (int n = 0; n < 2; ++n) acc[a][b][m][n] = (f32x4){0.f, 0.f, 0.f, 0.f};
        cur = nxt; cA = nA; cB = nB; ++ui;
        if constexpr (ALIGN_EPI) { if (wr == 1) PG8_BAR; }
    }
    PG8_WAIT_V(0);
    if constexpr (!ALIGN_EPI) { if (wr == 0) PG8_BAR; }
    PG8_BAR;
    if constexpr (Epi::AFTER_DRAIN) { E.fused(acc, cur, wr, wc, fr, fq, lds, wid, lane); S.done(cur); }
#undef PG8_SA
#undef PG8_SB
#undef PG8_STAGE
#undef PG8_LDA
#undef PG8_LDB
#undef PG8_MMA
#undef PG8_WAIT_V
#undef PG8_WAIT_L
#undef PG8_BAR
#undef PG8_SCHED
}
}
#define GAS __attribute__((address_space(1)))
#define LAS __attribute__((address_space(3)))
typedef unsigned short bf16;
typedef unsigned v4u __attribute__((ext_vector_type(4)));
typedef unsigned v2u __attribute__((ext_vector_type(2)));
typedef float f32x4 __attribute__((ext_vector_type(4)));
typedef float f32x2 __attribute__((ext_vector_type(2)));
typedef short bf16x8 __attribute__((ext_vector_type(8)));
#define LDS_WAIT() asm volatile("s_waitcnt lgkmcnt(0)" ::: "memory")
__device__ __forceinline__ unsigned f2bf(float f) { unsigned u = __builtin_bit_cast(unsigned, f); return (u + 0x7fffu + ((u >> 16) & 1u)) >> 16; }
__device__ __forceinline__ unsigned pk2(float lo, float hi) { return f2bf(lo) | (f2bf(hi) << 16); }
__device__ __forceinline__ float bf2f(unsigned short b) { return __uint_as_float(((unsigned)b) << 16); }
__device__ __forceinline__ float lo_bf(unsigned w) { return __uint_as_float(w << 16); }
__device__ __forceinline__ float hi_bf(unsigned w) { return __uint_as_float(w & 0xffff0000u); }
__device__ __forceinline__ float wave_sum(float v) {
#pragma unroll
    for (int o = 1; o < 64; o <<= 1) v += __shfl_xor(v, o);
    return v;
}
__device__ __forceinline__ float sigmoid_f(float x) { return 1.0f / (1.0f + __expf(-x)); }
__device__ __forceinline__ float silu_f(float x) { return x / (1.0f + __expf(-x)); }
__device__ __forceinline__ f32x4 mfma16(bf16x8 a, bf16x8 b, f32x4 c) { return __builtin_amdgcn_mfma_f32_16x16x32_bf16(a, b, c, 0, 0, 0); }
typedef short s16x4 __attribute__((ext_vector_type(4)));
__device__ __forceinline__ s16x4 ds_tr16(const LAS unsigned char* p) { return __builtin_amdgcn_ds_read_tr16_b64_v4i16((LAS s16x4*)p); }
#define XB_TMO      128
#define XB_XCNT(j)  (256  + 64 * (j))
#define XB_XSUB(j)  (1280 + 64 * (j))
#define XB_XGEN(j)  (2304 + 64 * (j))
#define XB_TOP      3328
#define XB_TOPGEN   3392
#define XCD_BAR_WORDS 3456
#define XB_SPIN_CAP (1u << 18)

__device__ __forceinline__ unsigned xb_ld(unsigned* p)              { return __hip_atomic_load(p, __ATOMIC_RELAXED, __HIP_MEMORY_SCOPE_AGENT); }
__device__ __forceinline__ unsigned xb_add(unsigned* p, unsigned v) { return __hip_atomic_fetch_add(p, v, __ATOMIC_RELAXED, __HIP_MEMORY_SCOPE_AGENT); }
__device__ __forceinline__ unsigned xb_xcc_id() { return (unsigned)__builtin_amdgcn_s_getreg((3 << 11) | 20) & 0xFu; }
#define XB_SPIN(cond, bar) do { unsigned _sp = 0; while (cond) { __builtin_amdgcn_s_sleep(1); \
    if ((++_sp & 255u) == 0u) { if (xb_ld(&(bar)[XB_TMO])) break; if (_sp > XB_SPIN_CAP) { atomicAdd(&(bar)[XB_TMO], 1u); break; } } } } while (0)

struct XcdBarrier {
    unsigned* bar; unsigned x;
    volatile LAS unsigned* st;
};

__device__ __forceinline__ XcdBarrier xcd_barrier_post(unsigned* bar, volatile LAS unsigned* st) {
    XcdBarrier b; b.bar = bar; b.x = xb_xcc_id(); b.st = st;
    if (threadIdx.x == 0) (void)xb_add(&bar[XB_XCNT(b.x)], 1u);
    return b;
}
__device__ __forceinline__ void xcd_barrier_complete(unsigned* bar, unsigned x, unsigned& nloc, unsigned& nx) {
    const unsigned G = gridDim.x * gridDim.y * gridDim.z;
    unsigned sum, cnt, mine, sp = 0u;
    for (;;) {
        sum = 0u; cnt = 0u; mine = 0u;
#pragma unroll
        for (unsigned j = 0; j < 16; ++j) { const unsigned c = xb_ld(&bar[XB_XCNT(j)]); sum += c; cnt += (c > 0u) ? 1u : 0u; mine = (j == x) ? c : mine; }
        if (sum == G) break;
        __builtin_amdgcn_s_sleep(1);
        if ((++sp & 255u) == 0u) { if (xb_ld(&bar[XB_TMO])) break; if (sp > XB_SPIN_CAP) { atomicAdd(&bar[XB_TMO], 1u); break; } }
    }
    nloc = mine > 0u ? mine : 1u; nx = cnt > 0u ? cnt : 1u;
}

__device__ __forceinline__ void xcd_barrier(const XcdBarrier& b) {
    asm volatile("s_waitcnt vmcnt(0)" ::: "memory");
    __syncthreads();
    if (threadIdx.x == 0) {
        unsigned* bar = b.bar;
        __builtin_amdgcn_s_waitcnt(0);
        unsigned nloc = b.st[0], nx = b.st[1];
        if (nloc == 0u) { xcd_barrier_complete(bar, b.x, nloc, nx); b.st[0] = nloc; b.st[1] = nx; }
        const unsigned old = xb_add(&bar[XB_XSUB(b.x)], 1u);
        const unsigned gen = old / nloc;
        if (old + 1u == (gen + 1u) * nloc) {
            __builtin_amdgcn_fence(__ATOMIC_RELEASE, "agent");
            asm volatile("s_waitcnt vmcnt(0)" ::: "memory");
            const unsigned og = xb_add(&bar[XB_TOP], 1u);
            const unsigned tg = og / nx;
            if (og + 1u == (tg + 1u) * nx) xb_add(&bar[XB_TOPGEN], 1u);
            else XB_SPIN(xb_ld(&bar[XB_TOPGEN]) == tg, bar);
            __builtin_amdgcn_fence(__ATOMIC_ACQUIRE, "agent");
            xb_add(&bar[XB_XGEN(b.x)], 1u);
            asm volatile("s_waitcnt vmcnt(0)" ::: "memory");
        } else {
            XB_SPIN(xb_ld(&bar[XB_XGEN(b.x)]) == gen, bar);
            __builtin_amdgcn_fence(__ATOMIC_ACQUIRE, "agent");
            asm volatile("s_waitcnt vmcnt(0)" ::: "memory");
        }
    }
    __syncthreads();
}

constexpr int BATCH = 4, SEQ = 2048, DM = 2048, MTOK = BATCH * SEQ, DFF = 5632, PLD = 6144, NIN_E = 5376, NIN_O = 6144;
constexpr int NPH = 34;
constexpr float ALPHA_DN = 1.6817928305074290f;
constexpr float LN_EPS = 1e-5f;
constexpr float LOG2E = 1.4426950408889634f;
constexpr size_t MiB = 1u << 20;
constexpr size_t WS_CTL = 0, CTL_ZERO_BYTES = 1 * MiB;
constexpr size_t WS_WIN = 2 * MiB, WIN_STRIDE = 24 * MiB;
constexpr size_t WS_WOUT = 98 * MiB, WOUT_STRIDE = 8 * MiB;
constexpr size_t WS_WGLU = 130 * MiB, WGLU_STRIDE = 2 * MiB;
constexpr size_t WS_WGU = 134 * MiB, WGU_STRIDE = 44 * MiB;
constexpr size_t WS_WDN = 310 * MiB, WDN_STRIDE = 22 * MiB;
constexpr size_t WS_X = 398 * MiB;
constexpr size_t WS_H = 462 * MiB;
constexpr size_t WS_PROJ = 494 * MiB;
constexpr size_t WS_MIX = 590 * MiB;
constexpr size_t WS_Y = 622 * MiB;
constexpr size_t WS_HID = 686 * MiB;
constexpr size_t WS_MOD = 774 * MiB;
constexpr size_t WS_YPRE = 775 * MiB;
constexpr size_t WS_ODN = 791 * MiB;
constexpr size_t WS_CHU = 823 * MiB, WS_CHW = 839 * MiB, WS_CHQD = 855 * MiB, WS_CHKT = 871 * MiB;
constexpr size_t WS_CHA = 887 * MiB;
constexpr size_t WS_CHGL = 895 * MiB;
constexpr size_t WS_S5END = 896 * MiB;
constexpr size_t WS_X2 = 897 * MiB;
constexpr size_t WS_END = 961 * MiB;
constexpr int CW_BAR = 4096;
constexpr int LDS_BYTES = 147456, LDS_MISC = 143360;

struct Args { const float* in[34]; float* out; unsigned char* ws; int ph_lo, ph_hi; unsigned rep, pad; };
typedef const __attribute__((address_space(4))) Args* KArgs;
__device__ __forceinline__ KArgs kargs() { KArgs p = (KArgs)__builtin_amdgcn_kernarg_segment_ptr(); asm volatile("" : "+s"(p)); return p; }

__device__ __forceinline__ int dest_row(int mode, int n) {
    if (mode == 1) return n < 4096 ? n : (n < 4112 ? n + 1024 : n - 16);
    if (mode == 2) return ((n >> 7) << 8) + (n & 127);
    if (mode == 3) return ((n >> 7) << 8) + 128 + (n & 127);
    return n;
}
__device__ __forceinline__ void transpose_item(const float* __restrict__ W, int K, int N, bf16* WT, int mode, LAS float* scr, int kb, int nb, int lane) {
    const int k0 = kb * 64, n0 = nb * 64, cq = lane & 15, rq = lane >> 4, n = n0 + 4 * cq;
#pragma unroll 4
    for (int i = 0; i < 16; ++i) { const int kk = 4 * i + rq; f32x4 v = (f32x4){0.f, 0.f, 0.f, 0.f};
        if (n < N) v = *(const f32x4*)(W + (size_t)(k0 + kk) * N + n);
        LAS float* s = scr + kk * 65 + 4 * cq; s[0] = v.x; s[1] = v.y; s[2] = v.z; s[3] = v.w; }
    LDS_WAIT();
    const int c = lane & 7;
#pragma unroll
    for (int j = 0; j < 8; ++j) { const int nn = 8 * j + (lane >> 3), ng = n0 + nn;
        if (ng < N) { const LAS float* s = scr + (8 * c) * 65 + nn;
            v4u o; o.x = pk2(s[0], s[65]); o.y = pk2(s[130], s[195]); o.z = pk2(s[260], s[325]); o.w = pk2(s[390], s[455]);
            *(v4u*)(WT + (size_t)dest_row(mode, ng) * K + k0 + 8 * c) = o; } }
    LDS_WAIT();
}
__device__ __forceinline__ void p0a_phase(LAS unsigned char* lds, KArgs A, int G) {
    int tid_ = threadIdx.x; asm volatile("" : "+v"(tid_)); const int tid = tid_, lane = tid & 63, wave = __builtin_amdgcn_readfirstlane(tid >> 6);
    unsigned char* ws = A->ws;
    {
        LAS float* cact = (LAS float*)lds;
        LAS float* red = (LAS float*)(lds + 32768);
        const float* c = A->in[1]; const float* ada_w = A->in[2]; const float* ada_b = A->in[3]; float* MOD = (float*)(ws + WS_MOD);
        for (int e = tid; e < 4 * 2048; e += 512) { const float cv = c[e]; cact[e] = cv / (1.0f + expf(-cv)); }
        __syncthreads();
        for (int it = blockIdx.x; it < 192; it += G) {
            const int layer = it / 48, cg = it % 48;
            const float* Wl = ada_w + (size_t)layer * 2048 * 12288 + cg * 256 + 4 * lane;
            f32x4 acc[4];
#pragma unroll
            for (int b = 0; b < 4; ++b) acc[b] = (f32x4){0.f, 0.f, 0.f, 0.f};
            const int kbeg = wave * 256;
#pragma unroll 2
            for (int k = kbeg; k < kbeg + 256; k += 4) {
                const f32x4 w0 = *(const f32x4*)(Wl + (size_t)(k + 0) * 12288), w1 = *(const f32x4*)(Wl + (size_t)(k + 1) * 12288);
                const f32x4 w2 = *(const f32x4*)(Wl + (size_t)(k + 2) * 12288), w3 = *(const f32x4*)(Wl + (size_t)(k + 3) * 12288);
#pragma unroll
                for (int b = 0; b < 4; ++b) { const f32x4 cv = *(const LAS f32x4*)(cact + b * 2048 + k); acc[b] += cv.x * w0 + cv.y * w1 + cv.z * w2 + cv.w * w3; }
            }
#pragma unroll
            for (int b = 0; b < 4; ++b) *(LAS f32x4*)(red + (wave * 4 + b) * 256 + 4 * lane) = acc[b];
            __syncthreads();
            { const int b = tid >> 7, c0 = 2 * (tid & 127); float s0 = 0.f, s1 = 0.f;
#pragma unroll
              for (int w = 0; w < 8; ++w) { s0 += red[(w * 4 + b) * 256 + c0]; s1 += red[(w * 4 + b) * 256 + c0 + 1]; }
              const int col = cg * 256 + c0;
              MOD[(size_t)(layer * 4 + b) * 12288 + col] = s0 + ada_b[layer * 12288 + col];
              MOD[(size_t)(layer * 4 + b) * 12288 + col + 1] = s1 + ada_b[layer * 12288 + col + 1]; }
            __syncthreads();
        }
    }
    {
        LAS float* scr = (LAS float*)(lds + wave * 16896);
        const int gw = blockIdx.x * 8 + wave, NGW = G * 8;
        constexpr int I_FF = 32 * 88, I_ABI = 32 * 81, I_CDI = 32 * 96, I_OUT = 32 * 32, I_GLU = 16 * 16;
        constexpr int NITEMS = 12 * I_FF + 2 * I_ABI + 2 * I_CDI + 4 * I_OUT + 2 * I_GLU;
        for (int it = gw; it < NITEMS; it += NGW) {
            int r = it;
            const float* W; int K, N, mode, NB; bf16* WT;
            if (r < 4 * I_FF) { const int l = r / I_FF; r -= l * I_FF; W = A->in[8] + (size_t)l * 2048 * DFF; K = 2048; N = DFF; mode = 2; NB = 88; WT = (bf16*)(ws + WS_WGU + l * WGU_STRIDE); }
            else if ((r -= 4 * I_FF) < 4 * I_FF) { const int l = r / I_FF; r -= l * I_FF; W = A->in[9] + (size_t)l * 2048 * DFF; K = 2048; N = DFF; mode = 3; NB = 88; WT = (bf16*)(ws + WS_WGU + l * WGU_STRIDE); }
            else if ((r -= 4 * I_FF) < 4 * I_FF) { const int l = r / I_FF; r -= l * I_FF; W = A->in[10] + (size_t)l * DFF * 2048; K = DFF; N = 2048; mode = 0; NB = 32; WT = (bf16*)(ws + WS_WDN + l * WDN_STRIDE); }
            else if ((r -= 4 * I_FF) < 2 * I_ABI) { const int j = r / I_ABI; r -= j * I_ABI; W = A->in[11] + (size_t)j * 2048 * 5136; K = 2048; N = 5136; mode = 1; NB = 81; WT = (bf16*)(ws + WS_WIN + (2 * j) * WIN_STRIDE); }
            else if ((r -= 2 * I_ABI) < 2 * I_CDI) { const int j = r / I_CDI; r -= j * I_CDI; W = A->in[26] + (size_t)j * 2048 * 6144; K = 2048; N = 6144; mode = 0; NB = 96; WT = (bf16*)(ws + WS_WIN + (2 * j + 1) * WIN_STRIDE); }
            else if ((r -= 2 * I_CDI) < 2 * I_OUT) { const int j = r / I_OUT; r -= j * I_OUT; W = A->in[12] + (size_t)j * 2048 * 2048; K = 2048; N = 2048; mode = 0; NB = 32; WT = (bf16*)(ws + WS_WOUT + (2 * j) * WOUT_STRIDE); }
            else if ((r -= 2 * I_OUT) < 2 * I_OUT) { const int j = r / I_OUT; r -= j * I_OUT; W = A->in[27] + (size_t)j * 2048 * 2048; K = 2048; N = 2048; mode = 0; NB = 32; WT = (bf16*)(ws + WS_WOUT + (2 * j + 1) * WOUT_STRIDE); }
            else { r -= 2 * I_OUT; const int j = r / I_GLU; r -= j * I_GLU; W = A->in[25] + (size_t)j * 1024 * 1024; K = 1024; N = 1024; mode = 0; NB = 16; WT = (bf16*)(ws + WS_WGLU + j * WGLU_STRIDE); }
            transpose_item(W, K, N, WT, mode, scr, r / NB, r % NB, lane);
        }
    }
}
__device__ __forceinline__ void modulate_phase(const float* X, const float* MODl  , int sh_off, int sc_off, bf16* H, int G) {
    const size_t nth = (size_t)G * 512;
    int tid_ = threadIdx.x; asm volatile("" : "+v"(tid_));
    for (size_t e = (size_t)blockIdx.x * 512 + tid_; e < (size_t)MTOK * DM / 8; e += nth) {
        const int m = (int)(e >> 8), c8 = (int)(e & 255) * 8, b = m >> 11;
        const f32x4 x0 = *(const f32x4*)(X + (size_t)m * DM + c8), x1 = *(const f32x4*)(X + (size_t)m * DM + c8 + 4);
        const float* mb = MODl + (size_t)b * 12288;
        const f32x4 s0 = *(const f32x4*)(mb + sc_off + c8), s1 = *(const f32x4*)(mb + sc_off + c8 + 4);
        const f32x4 h0 = *(const f32x4*)(mb + sh_off + c8), h1 = *(const f32x4*)(mb + sh_off + c8 + 4);
        const f32x4 o0 = x0 * (1.0f + s0) + h0, o1 = x1 * (1.0f + s1) + h1;
        v4u w; w.x = pk2(o0.x, o0.y); w.y = pk2(o0.z, o0.w); w.z = pk2(o1.x, o1.y); w.w = pk2(o1.z, o1.w);
        *(v4u*)(H + (size_t)m * DM + c8) = w;
    }
}
__device__ __forceinline__ void ln_phase(const float* Xin, const float* Y, float* Xout, bf16* H, const float* MODg  ,
                                         const float* lng, const float* lnb, const float* MODn  , int sh_off, int sc_off, int G) {
    int tid_ = threadIdx.x; asm volatile("" : "+v"(tid_)); const int lane = tid_ & 63, gw = blockIdx.x * 8 + (tid_ >> 6), NGW = G * 8;
    for (int m = gw; m < MTOK; m += NGW) {
        const int b = m >> 11;
        const float* xr = Xin + (size_t)m * DM + 4 * lane; const float* yr = Y + (size_t)m * DM + 4 * lane; const float* gr = MODg + (size_t)b * 12288 + 4 * lane;
        f32x4 v[8]; float s = 0.f;
#pragma unroll
        for (int j = 0; j < 8; ++j) { const f32x4 x = *(const f32x4*)(xr + 256 * j), y = *(const f32x4*)(yr + 256 * j), g = *(const f32x4*)(gr + 256 * j);
            v[j] = ALPHA_DN * x + (1.0f + g) * y; s += (v[j].x + v[j].y) + (v[j].z + v[j].w); }
        const float mean = wave_sum(s) * (1.0f / DM); float s2 = 0.f;
#pragma unroll
        for (int j = 0; j < 8; ++j) { v[j] = v[j] - mean; s2 += (v[j].x * v[j].x + v[j].y * v[j].y) + (v[j].z * v[j].z + v[j].w * v[j].w); }
        const float rstd = 1.0f / sqrtf(wave_sum(s2) * (1.0f / DM) + LN_EPS);
#pragma unroll
        for (int j = 0; j < 8; ++j) { const int col = 4 * lane + 256 * j;
            const f32x4 o = v[j] * rstd * *(const f32x4*)(lng + col) + *(const f32x4*)(lnb + col);
            *(f32x4*)(Xout + (size_t)m * DM + col) = o;
            if (MODn) { const float* mb = MODn + (size_t)b * 12288 + col; const f32x4 hh = o * (1.0f + *(const f32x4*)(mb + sc_off)) + *(const f32x4*)(mb + sh_off);
                v2u w; w.x = pk2(hh.x, hh.y); w.y = pk2(hh.z, hh.w); *(v2u*)(H + (size_t)m * DM + col) = w; } }
    }
}

__device__ __forceinline__ void shortconv_phase(const bf16* PROJ, const float* cw  , bf16* MIX, int G) {
    const size_t nth = (size_t)G * 512;
    int tid_ = threadIdx.x; asm volatile("" : "+v"(tid_));
    for (size_t e = (size_t)blockIdx.x * 512 + tid_; e < (size_t)MTOK * 128; e += nth) {
        const int m = (int)(e >> 7), c8 = (int)(e & 127) * 8, t = m & (SEQ - 1);
        float acc[8];
#pragma unroll
        for (int i = 0; i < 8; ++i) acc[i] = 0.f;
#pragma unroll
        for (int kk = 0; kk < 3; ++kk) {
            if (t - 2 + kk >= 0) {
                const bf16* row = PROJ + (size_t)(m - 2 + kk) * PLD;
                const v4u g = *(const v4u*)(row + 1024 + c8), x = *(const v4u*)(row + 2048 + c8);
                const f32x4 w0 = *(const f32x4*)(cw + kk * 1024 + c8), w1 = *(const f32x4*)(cw + kk * 1024 + c8 + 4);
                acc[0] += w0.x * lo_bf(g.x) * lo_bf(x.x); acc[1] += w0.y * hi_bf(g.x) * hi_bf(x.x);
                acc[2] += w0.z * lo_bf(g.y) * lo_bf(x.y); acc[3] += w0.w * hi_bf(g.y) * hi_bf(x.y);
                acc[4] += w1.x * lo_bf(g.z) * lo_bf(x.z); acc[5] += w1.y * hi_bf(g.z) * hi_bf(x.z);
                acc[6] += w1.z * lo_bf(g.w) * lo_bf(x.w); acc[7] += w1.w * hi_bf(g.w) * hi_bf(x.w);
            }
        }
        const v4u gb = *(const v4u*)(PROJ + (size_t)m * PLD + c8);
        v4u w; w.x = pk2(lo_bf(gb.x) * acc[0], hi_bf(gb.x) * acc[1]); w.y = pk2(lo_bf(gb.y) * acc[2], hi_bf(gb.y) * acc[3]);
        w.z = pk2(lo_bf(gb.z) * acc[4], hi_bf(gb.z) * acc[5]); w.w = pk2(lo_bf(gb.w) * acc[6], hi_bf(gb.w) * acc[7]);
        *(v4u*)(MIX + (size_t)m * DM + c8) = w;
    }
}

__device__ __forceinline__ void attn_phase(LAS unsigned char* lds, const bf16* PROJ, bf16* MIX, const float* lq1, const float* lk1, const float* lq2, const float* lk2,
                                           const float* norm_g, float lambda_init, int G) {
    int tid_ = threadIdx.x; asm volatile("" : "+v"(tid_)); const int tid = tid_, lane = tid & 63, w = __builtin_amdgcn_readfirstlane(tid >> 6), q4 = lane >> 4, l15 = lane & 15, mi = w >> 2, wq = w & 3;
    float lam;
    { float s1 = lq1[lane] * lk1[lane] + lq1[lane + 64] * lk1[lane + 64], s2 = lq2[lane] * lk2[lane] + lq2[lane + 64] * lk2[lane + 64];
      s1 = wave_sum(s1); s2 = wave_sum(s2); lam = expf(s1) - expf(s2) + lambda_init; }
    LAS unsigned char* K0 = lds; LAS unsigned char* K1 = lds + 17408; LAS unsigned char* VT = lds + 34816; LAS unsigned char* XCH = lds;
    LAS unsigned char* Kmine = mi ? K1 : K0;
    const LAS unsigned char* vtr0 = VT + (4 * q4 + (l15 >> 2)) * 544 + (l15 & 3) * 8;
    const float c1 = 0.08838834764831845f * LOG2E;
    for (int u = blockIdx.x; u < 256; u += G) {
        const int b = u >> 6, h = (u >> 4) & 3, p = u & 15;
        const float sl2 = exp2f(-2.0f * (float)(h + 1)) * LOG2E;
        const bf16* base = PROJ + (size_t)b * SEQ * PLD;
        for (int half = 0; half < 2; ++half) {
            const int qb = half ? 31 - p : p;
            const int qloc = 16 * wq + l15;
            bf16x8 qf[4];
            { const bf16* qp = base + (size_t)(64 * qb + qloc) * PLD + 3072 + h * 256 + mi * 128 + 8 * q4;
#pragma unroll
              for (int sk = 0; sk < 4; ++sk) qf[sk] = *(const bf16x8*)(qp + 32 * sk); }
            f32x4 O[16];
#pragma unroll
            for (int mt = 0; mt < 16; ++mt) O[mt] = (f32x4){0.f, 0.f, 0.f, 0.f};
            float m_run = -1e30f, l_part = 0.f;
            v4u rk0[2], rk1[2], rv[4];
#define ATT_LOAD(kt_) do { const bf16* tb = base + (size_t)(64 * (kt_)) * PLD + h * 256; \
                _Pragma("unroll") for (int j = 0; j < 2; ++j) { const int c = tid + 512 * j, key = c >> 4, ch = c & 15; \
                    rk0[j] = *(const v4u*)(tb + (size_t)key * PLD + 4096 + 8 * ch); rk1[j] = *(const v4u*)(tb + (size_t)key * PLD + 4096 + 128 + 8 * ch); } \
                _Pragma("unroll") for (int j = 0; j < 4; ++j) { const int c = tid + 512 * j, key = c >> 5, ch = c & 31; rv[j] = *(const v4u*)(tb + (size_t)key * PLD + 5120 + 8 * ch); } } while (0)
            ATT_LOAD(0);
            for (int kt = 0; kt <= qb; ++kt) {
                __syncthreads();
#pragma unroll
                for (int j = 0; j < 2; ++j) { const int c = tid + 512 * j, key = c >> 4, ch = c & 15;
                    *(LAS v4u*)(K0 + key * 272 + ch * 16) = rk0[j]; *(LAS v4u*)(K1 + key * 272 + ch * 16) = rk1[j]; }
#pragma unroll
                for (int j = 0; j < 4; ++j) { const int c = tid + 512 * j, key = c >> 5, ch = c & 31; *(LAS v4u*)(VT + key * 544 + ch * 16) = rv[j]; }
                __syncthreads();
                if (kt < qb) ATT_LOAD(kt + 1);
                f32x4 s[4];
#pragma unroll
                for (int t16 = 0; t16 < 4; ++t16) { f32x4 acc = (f32x4){0.f, 0.f, 0.f, 0.f};
#pragma unroll
                    for (int sk = 0; sk < 4; ++sk) { const bf16x8 a = *(const LAS bf16x8*)(Kmine + (16 * t16 + l15) * 272 + (32 * sk + 8 * q4) * 2); acc = mfma16(a, qf[sk], acc); }
                    s[t16] = acc; }
                const int dq = 64 * (qb - kt) + qloc; const bool diag = (kt == qb);
                float mx = -1e30f;
#pragma unroll
                for (int t16 = 0; t16 < 4; ++t16)
#pragma unroll
                    for (int r = 0; r < 4; ++r) { const int kl = 16 * t16 + 4 * q4 + r; float v = s[t16][r] * c1 - sl2 * (float)(dq - kl);
                        if (diag && kl > qloc) v = -1e30f; s[t16][r] = v; mx = fmaxf(mx, v); }
                mx = fmaxf(mx, __shfl_xor(mx, 16)); mx = fmaxf(mx, __shfl_xor(mx, 32));
                const float mn = fmaxf(m_run, mx), alpha = __builtin_amdgcn_exp2f(m_run - mn); m_run = mn;
                float ps = 0.f;
#pragma unroll
                for (int t16 = 0; t16 < 4; ++t16)
#pragma unroll
                    for (int r = 0; r < 4; ++r) { const float pv = __builtin_amdgcn_exp2f(s[t16][r] - mn); s[t16][r] = pv; ps += pv; }
                l_part = l_part * alpha + ps;
#pragma unroll
                for (int mt = 0; mt < 16; ++mt) O[mt] = O[mt] * alpha;
                bf16x8 pf[2];
#pragma unroll
                for (int ks = 0; ks < 2; ++ks) { v4u pw; pw.x = pk2(s[2 * ks][0], s[2 * ks][1]); pw.y = pk2(s[2 * ks][2], s[2 * ks][3]); pw.z = pk2(s[2 * ks + 1][0], s[2 * ks + 1][1]); pw.w = pk2(s[2 * ks + 1][2], s[2 * ks + 1][3]);
                    pf[ks] = __builtin_bit_cast(bf16x8, pw); }
#pragma unroll
                for (int mt = 0; mt < 16; ++mt)
#pragma unroll
                    for (int ks = 0; ks < 2; ++ks) { const LAS unsigned char* vp = vtr0 + ks * 17408 + mt * 32;
                        const s16x4 a0 = ds_tr16(vp), a1 = ds_tr16(vp + 8704);
                        const bf16x8 av = (bf16x8){a0[0], a0[1], a0[2], a0[3], a1[0], a1[1], a1[2], a1[3]};
                        O[mt] = mfma16(av, pf[ks], O[mt]); }
            }
#undef ATT_LOAD
            float lt = l_part; lt += __shfl_xor(lt, 16); lt += __shfl_xor(lt, 32); const float inv = 1.0f / lt;
            __syncthreads();
            if (mi == 1) {
#pragma unroll
                for (int mt = 0; mt < 16; ++mt) *(LAS f32x4*)(XCH + ((wq * 16 + mt) * 64 + lane) * 16) = O[mt] * inv;
            }
            __syncthreads();
            if (mi == 0) {
                float ss = 0.f;
#pragma unroll
                for (int mt = 0; mt < 16; ++mt) { const f32x4 o1 = *(const LAS f32x4*)(XCH + ((wq * 16 + mt) * 64 + lane) * 16); const f32x4 o = O[mt] * inv - lam * o1; O[mt] = o;
                    ss += (o.x * o.x + o.y * o.y) + (o.z * o.z + o.w * o.w); }
                ss += __shfl_xor(ss, 16); ss += __shfl_xor(ss, 32);
                const float rs = (1.0f / sqrtf(ss * (1.0f / 256.0f) + LN_EPS)) * (1.0f - lambda_init);
                bf16* orow = MIX + (size_t)(b * SEQ + 64 * qb + qloc) * DM + 1024 + h * 256 + 4 * q4;
#pragma unroll
                for (int mt = 0; mt < 16; ++mt) { const f32x4 g = *(const f32x4*)(norm_g + 16 * mt + 4 * q4); const f32x4 o = O[mt] * rs * g;
                    v2u wv; wv.x = pk2(o.x, o.y); wv.y = pk2(o.z, o.w); *(v2u*)(orow + 16 * mt) = wv; }
            }
            __syncthreads();
        }
    }
}

__device__ __forceinline__ float softplus_f(float x) { return x > 20.0f ? x : log1pf(expf(x)); }
__device__ __forceinline__ void dn_prep_phase(LAS unsigned char* lds, const bf16* PROJ, const float* conv_w  , const float* a_log, const float* dt_bias,
                                              bf16* CHU, bf16* CHW, bf16* CHQD, bf16* CHKT, bf16* CHA, float* CHGL, int G) {
    int tid_ = threadIdx.x; asm volatile("" : "+v"(tid_)); const int tid = tid_, lane = tid & 63, w = __builtin_amdgcn_readfirstlane(tid >> 6), q4 = lane >> 4, l15 = lane & 15;
    LAS unsigned char* Q16 = lds; LAS unsigned char* K16 = lds + 17408;
    LAS float* VF = (LAS float*)(lds + 34816); LAS float* WF = (LAS float*)(lds + 68608);
    LAS float* LF = (LAS float*)(lds + 102400);
    LAS float* RQ = (LAS float*)(lds + 119808); LAS float* RK = RQ + 64; LAS float* BETA = RQ + 128; LAS float* GC = RQ + 192;
    for (int u = blockIdx.x; u < 1024; u += G) {
        const int b = u >> 8, h = (u >> 5) & 7, n = u & 31, m0 = b * SEQ + 64 * n, t0 = 64 * n;
#pragma unroll
        for (int sel = 0; sel < 3; ++sel) {
            const int col = sel * 1024 + h * 128 + 2 * lane;
            float cw0[4], cw1[4];
#pragma unroll
            for (int kk = 0; kk < 4; ++kk) { const f32x2 c2 = *(const f32x2*)(conv_w + kk * 3072 + col); cw0[kk] = c2.x; cw1[kk] = c2.y; }
            unsigned xr[11];
#pragma unroll
            for (int r = 0; r < 11; ++r) { const int tl = 8 * w + r - 3; xr[r] = (t0 + tl >= 0) ? *(const unsigned*)(PROJ + (size_t)(m0 + tl) * PLD + col) : 0u; }
#pragma unroll
            for (int t = 0; t < 8; ++t) {
                float y0 = 0.f, y1 = 0.f;
#pragma unroll
                for (int kk = 0; kk < 4; ++kk) { y0 += cw0[kk] * lo_bf(xr[t + kk]); y1 += cw1[kk] * hi_bf(xr[t + kk]); }
                y0 = silu_f(y0); y1 = silu_f(y1);
                const int i = 8 * w + t;
                if (sel < 2) { const float ss = wave_sum(y0 * y0 + y1 * y1); const float r = 1.0f / sqrtf(ss + 1e-6f);
                    if (lane == 0) { if (sel == 0) RQ[i] = r * 0.08838834764831845f; else RK[i] = r; }
                    *(LAS unsigned*)((sel == 0 ? Q16 : K16) + i * 272 + lane * 4) = pk2(y0, y1); }
                else *(LAS f32x2*)(VF + i * 132 + 2 * lane) = (f32x2){y0, y1};
            }
        }
        if (w == 0) {
            const float bv = bf2f(PROJ[(size_t)(m0 + lane) * PLD + 5120 + h]), av = bf2f(PROJ[(size_t)(m0 + lane) * PLD + 5128 + h]);
            float g = -expf(a_log[h]) * softplus_f(av + dt_bias[h]);
#pragma unroll
            for (int o = 1; o < 64; o <<= 1) { const float tv = __shfl_up(g, o); if (lane >= o) g += tv; }
            BETA[lane] = sigmoid_f(bv); GC[lane] = g;
        }
        __syncthreads();
        {
            const int prod = w >> 2, mt = w & 3; const LAS unsigned char* Ab = prod ? Q16 : K16;
            bf16x8 af[4];
#pragma unroll
            for (int sk = 0; sk < 4; ++sk) af[sk] = *(const LAS bf16x8*)(Ab + (16 * mt + l15) * 272 + (32 * sk + 8 * q4) * 2);
#pragma unroll
            for (int nt = 0; nt < 4; ++nt) { f32x4 acc = (f32x4){0.f, 0.f, 0.f, 0.f};
#pragma unroll
                for (int sk = 0; sk < 4; ++sk) { const bf16x8 bb = *(const LAS bf16x8*)(K16 + (16 * nt + l15) * 272 + (32 * sk + 8 * q4) * 2); acc = mfma16(af[sk], bb, acc); }
                const int jn = 16 * nt + l15; const float rkj = RK[jn], gj = GC[jn];
#pragma unroll
                for (int r = 0; r < 4; ++r) { const int i = 16 * mt + 4 * q4 + r; const float dec = expf(fminf(GC[i] - gj, 0.0f));
                    if (prod == 0) LF[i * 68 + jn] = (jn < i) ? acc[r] * BETA[i] * RK[i] * rkj * dec : 0.0f;
                    else CHA[(size_t)u * 4096 + i * 64 + jn] = (bf16)f2bf((jn <= i) ? acc[r] * RQ[i] * rkj * dec : 0.0f); }
            }
        }
#pragma unroll 4
        for (int it = 0; it < 16; ++it) { const int e = tid + 512 * it, i = e >> 7, d = e & 127;
            const float kn = bf2f(*(const LAS unsigned short*)(K16 + i * 272 + d * 2)) * RK[i], qn = bf2f(*(const LAS unsigned short*)(Q16 + i * 272 + d * 2)) * RQ[i];
            const float eg = expf(GC[i]), be = BETA[i];
            CHQD[(size_t)u * 8192 + e] = (bf16)f2bf(qn * eg);
            WF[i * 132 + d] = kn * be * eg; VF[i * 132 + d] *= be; }
#pragma unroll 4
        for (int it = 0; it < 16; ++it) { const int e = tid + 512 * it, d = e >> 6, i = e & 63;
            const float kn = bf2f(*(const LAS unsigned short*)(K16 + i * 272 + d * 2)) * RK[i];
            CHKT[(size_t)u * 8192 + e] = (bf16)f2bf(kn * expf(GC[63] - GC[i])); }
        __syncthreads();
        if (tid < 256) {
            const LAS float* X = (tid < 128) ? (VF + tid) : (WF + (tid - 128));
            const LAS float* LFo = LF; asm volatile("" : "+v"(LFo)); asm volatile("" : "+v"(X));
            float x[64];
#pragma unroll
            for (int i = 0; i < 64; ++i) {
                float acc = X[i * 132];
#pragma unroll
                for (int jb = 0; jb < (i + 3) / 4; ++jb) { const f32x4 l4 = *(const LAS f32x4*)(LFo + i * 68 + 4 * jb);
                    if (4 * jb + 0 < i) acc -= l4.x * x[4 * jb + 0];
                    if (4 * jb + 1 < i) acc -= l4.y * x[4 * jb + 1];
                    if (4 * jb + 2 < i) acc -= l4.z * x[4 * jb + 2];
                    if (4 * jb + 3 < i) acc -= l4.w * x[4 * jb + 3]; }
                x[i] = acc;
            }
            bf16* dst = (tid < 128) ? (CHU + (size_t)u * 8192 + tid) : (CHW + (size_t)u * 8192 + (tid - 128));
#pragma unroll
            for (int i = 0; i < 64; ++i) dst[i * 128] = (bf16)f2bf(x[i]);
            if (tid == 0) CHGL[u] = expf(GC[63]);
        }
        __syncthreads();
    }
}

__device__ __forceinline__ void dn_scan_phase(LAS unsigned char* lds, const bf16* CHU, const bf16* CHW, const bf16* CHQD, const bf16* CHKT, const bf16* CHA, const float* CHGL, float* ODN, int G) {
    int tid_ = threadIdx.x; asm volatile("" : "+v"(tid_)); const int tid = tid_, lane = tid & 63, w = __builtin_amdgcn_readfirstlane(tid >> 6), q4 = lane >> 4, l15 = lane & 15;
    LAS unsigned char* Wt = lds; LAS unsigned char* QDt = lds + 17408; LAS unsigned char* KTt = lds + 34816; LAS unsigned char* At = lds + 53248;
    LAS unsigned char* Ut = lds + 62464; LAS unsigned char* St = lds + 67584; LAS unsigned char* VNt = lds + 76288;
    const int mt = w >> 1, nt = w & 1;
    for (int u = blockIdx.x; u < 128; u += G) {
        const int bh = u >> 2, sl = u & 3, b = bh >> 3, h = bh & 7;
        __syncthreads();
        for (int e = tid; e < 8704 / 4; e += 512) ((LAS unsigned*)St)[e] = 0u;
        f32x4 Sr[2]; Sr[0] = (f32x4){0.f, 0.f, 0.f, 0.f}; Sr[1] = (f32x4){0.f, 0.f, 0.f, 0.f};
        v4u rw[2], rq[2], rk[2], ra, ru;
        ru = (v4u){0u, 0u, 0u, 0u};
#define DNS_LOAD(ch_) do { const size_t cb = (size_t)(ch_) * 8192; \
            _Pragma("unroll") for (int j = 0; j < 2; ++j) { const int c = tid + 512 * j; rw[j] = *(const v4u*)(CHW + cb + 8 * c); rq[j] = *(const v4u*)(CHQD + cb + 8 * c); rk[j] = *(const v4u*)(CHKT + cb + 8 * c); } \
            ra = *(const v4u*)(CHA + (size_t)(ch_) * 4096 + 8 * tid); \
            if (tid < 256) ru = *(const v4u*)(CHU + cb + (tid >> 2) * 128 + 32 * sl + (tid & 3) * 8); } while (0)
        DNS_LOAD(bh * 32);
        for (int n = 0; n < 32; ++n) {
            const int chunk = bh * 32 + n, m0 = b * SEQ + 64 * n;
#pragma unroll
            for (int j = 0; j < 2; ++j) { const int c = tid + 512 * j;
                *(LAS v4u*)(Wt + (c >> 4) * 272 + (c & 15) * 16) = rw[j]; *(LAS v4u*)(QDt + (c >> 4) * 272 + (c & 15) * 16) = rq[j];
                *(LAS v4u*)(KTt + (c >> 3) * 144 + (c & 7) * 16) = rk[j]; }
            *(LAS v4u*)(At + (tid >> 3) * 144 + (tid & 7) * 16) = ra;
            if (tid < 256) *(LAS v4u*)(Ut + (tid >> 2) * 80 + (tid & 3) * 16) = ru;
            __syncthreads();
            if (n < 31) DNS_LOAD(chunk + 1);
            const float gl = CHGL[chunk];
            {
                f32x4 acc = (f32x4){0.f, 0.f, 0.f, 0.f};
#pragma unroll
                for (int sk = 0; sk < 4; ++sk) { const bf16x8 a = *(const LAS bf16x8*)(Wt + (16 * mt + l15) * 272 + (32 * sk + 8 * q4) * 2);
                    const bf16x8 bb = *(const LAS bf16x8*)(St + (16 * nt + l15) * 272 + (32 * sk + 8 * q4) * 2); acc = mfma16(a, bb, acc); }
                float vn[4];
#pragma unroll
                for (int r = 0; r < 4; ++r) vn[r] = bf2f(*(const LAS unsigned short*)(Ut + (16 * mt + 4 * q4 + r) * 80 + (16 * nt + l15) * 2)) - acc[r];
                v2u pw; pw.x = pk2(vn[0], vn[1]); pw.y = pk2(vn[2], vn[3]);
                *(LAS v2u*)(VNt + (16 * nt + l15) * 144 + (16 * mt + 4 * q4) * 2) = pw;
            }
            __syncthreads();
            {
                f32x4 acc = (f32x4){0.f, 0.f, 0.f, 0.f};
#pragma unroll
                for (int sk = 0; sk < 4; ++sk) { const bf16x8 a = *(const LAS bf16x8*)(QDt + (16 * mt + l15) * 272 + (32 * sk + 8 * q4) * 2);
                    const bf16x8 bb = *(const LAS bf16x8*)(St + (16 * nt + l15) * 272 + (32 * sk + 8 * q4) * 2); acc = mfma16(a, bb, acc); }
#pragma unroll
                for (int sk = 0; sk < 2; ++sk) { const bf16x8 a = *(const LAS bf16x8*)(At + (16 * mt + l15) * 144 + (32 * sk + 8 * q4) * 2);
                    const bf16x8 bb = *(const LAS bf16x8*)(VNt + (16 * nt + l15) * 144 + (32 * sk + 8 * q4) * 2); acc = mfma16(a, bb, acc); }
                float* op = ODN + (size_t)(m0 + 16 * mt + 4 * q4) * 1024 + h * 128 + 32 * sl + 16 * nt + l15;
#pragma unroll
                for (int r = 0; r < 4; ++r) op[(size_t)r * 1024] = acc[r];
            }
#pragma unroll
            for (int dvt = 0; dvt < 2; ++dvt) { f32x4 acc = Sr[dvt] * gl;
#pragma unroll
                for (int sk = 0; sk < 2; ++sk) { const bf16x8 a = *(const LAS bf16x8*)(KTt + (16 * w + l15) * 144 + (32 * sk + 8 * q4) * 2);
                    const bf16x8 bb = *(const LAS bf16x8*)(VNt + (16 * dvt + l15) * 144 + (32 * sk + 8 * q4) * 2); acc = mfma16(a, bb, acc); }
                Sr[dvt] = acc; }
            __syncthreads();
#pragma unroll
            for (int dvt = 0; dvt < 2; ++dvt) { v2u pw; pw.x = pk2(Sr[dvt][0], Sr[dvt][1]); pw.y = pk2(Sr[dvt][2], Sr[dvt][3]);
                *(LAS v2u*)(St + (16 * dvt + l15) * 272 + (16 * w + 4 * q4) * 2) = pw; }
        }
#undef DNS_LOAD
    }
}
__device__ __forceinline__ void dn_gate_phase(const float* ODN, const bf16* PROJ, const float* norm_g, bf16* MIX, int G) {
    int tid_ = threadIdx.x; asm volatile("" : "+v"(tid_)); const int lane = tid_ & 63, gw = blockIdx.x * 8 + (tid_ >> 6), NGW = G * 8;
    const f32x2 g2 = *(const f32x2*)(norm_g + 2 * lane);
    for (int it = gw; it < MTOK * 8; it += NGW) { const int m = it >> 3, h = it & 7;
        const f32x2 o = *(const f32x2*)(ODN + (size_t)m * 1024 + h * 128 + 2 * lane);
        const float ss = wave_sum(o.x * o.x + o.y * o.y), r = 1.0f / sqrtf(ss * (1.0f / 128.0f) + LN_EPS);
        const unsigned zz = *(const unsigned*)(PROJ + (size_t)m * PLD + 3072 + h * 128 + 2 * lane);
        *(unsigned*)(MIX + (size_t)m * DM + h * 128 + 2 * lane) = pk2(o.x * r * g2.x * silu_f(lo_bf(zz)), o.y * r * g2.y * silu_f(hi_bf(zz))); }
}

__device__ __forceinline__ void sincos_cw(float x, float& s, float& c) {
    const float kf = rintf(x * 0.6366197723675814f); const int k = (int)kf;
    float r = fmaf(kf, -1.5703125f, x); r = fmaf(kf, -4.837512969970703125e-4f, r); r = fmaf(kf, -7.54978995489188216e-8f, r);
    const float r2 = r * r;
    const float sp = r + r * r2 * (-1.6666654611e-1f + r2 * (8.3321608736e-3f + r2 * (-1.9515295891e-4f)));
    const float cp = 1.0f - 0.5f * r2 + r2 * r2 * (4.166664568298827e-2f + r2 * (-1.388731625493765e-3f + r2 * 2.443315711809948e-5f));
    const int qd = k & 3;
    s = (qd == 0) ? sp : (qd == 1) ? cp : (qd == 2) ? -sp : -cp;
    c = (qd == 0) ? cp : (qd == 1) ? -sp : (qd == 2) ? -cp : sp;
}
__device__ __forceinline__ float gelu_tanh_f(float y) { const float a = 0.7978845608028654f * (y + 0.044715f * y * y * y); const float t = 1.0f - 2.0f / (__expf(2.0f * a) + 1.0f); return 0.5f * y * (1.0f + t); }
__device__ __forceinline__ void s5_phase(LAS unsigned char* lds, const bf16* PROJ, const float* a_re, const float* a_im, const float* b_re, const float* b_im, const float* c_re, const float* c_im,
                                         const float* dvec, const float* log_dt, bf16* YPRE, int first, int nblk) {
    int tid_ = threadIdx.x; asm volatile("" : "+v"(tid_)); const int tid = tid_, lane = tid & 63, w = __builtin_amdgcn_readfirstlane(tid >> 6), q4 = lane >> 4, l15 = lane & 15;
    LAS unsigned char* UL = lds;
    LAS float* EL = (LAS float*)(lds + 33792);
    LAS unsigned char* S0L = lds + 67584;
    LAS unsigned short* KTAB = (LAS unsigned short*)(lds + 84992);
    LAS f32x2* POW = (LAS f32x2*)(lds + 33792);
    LAS f32x2* BB = (LAS f32x2*)(lds + 42496);
    LAS f32x2* CC = (LAS f32x2*)(lds + 50688);
    for (int bi = (int)blockIdx.x - first; bi < 256; bi += nblk) {
        const int b = bi >> 6, g = bi & 63;
        const float dt = expf(log_dt[g]);
        __syncthreads();
        for (int e = tid; e < 17 * 64; e += 512) { const int tau = e >> 6, p = e & 63; const float zr = a_re[g * 64 + p] * dt, zi = a_im[g * 64 + p] * dt;
            const float er = expf((float)tau * zr); float sn, cs; sincos_cw((float)tau * zi, sn, cs); POW[e] = (f32x2){er * cs, er * sn}; }
        for (int e = tid; e < 1024; e += 512) { const int p = e >> 4;
            const float are = a_re[g * 64 + p], aim = a_im[g * 64 + p]; const float er = expf(are * dt); float sn, cs; sincos_cw(aim * dt, sn, cs);
            const float nr = er * cs - 1.0f, ni = er * sn, den = 1.0f / (are * are + aim * aim); const float cr = (nr * are + ni * aim) * den, ci = (ni * are - nr * aim) * den;
            const float br = b_re[(size_t)g * 1024 + e], bim = b_im[(size_t)g * 1024 + e];
            BB[e] = (f32x2){cr * br - ci * bim, cr * bim + ci * br};
            CC[e] = (f32x2){c_re[(size_t)g * 1024 + e], c_im[(size_t)g * 1024 + e]}; }
        __syncthreads();
        for (int e = tid; e < 4096; e += 512) { const int tau = e >> 8, c = (e >> 4) & 15, cp = e & 15; float acc = (tau == 0 && c == cp) ? dvec[g * 16 + c] : 0.0f;
#pragma unroll 4
            for (int p = 0; p < 64; ++p) { const f32x2 cc = CC[c * 64 + p], pw = POW[tau * 64 + p], bb = BB[p * 16 + cp];
                const float xr = cc.x * pw.x - cc.y * pw.y, xi = cc.x * pw.y + cc.y * pw.x; acc += xr * bb.x - xi * bb.y; }
            KTAB[e] = (unsigned short)f2bf(acc); }
        bf16x8 afA[8], afC[2][4];
        { const int p = 8 * w + (l15 >> 1), ri = l15 & 1;
#pragma unroll
          for (int ks = 0; ks < 8; ++ks) { const int j = 2 * ks + (q4 >> 1), c0 = 8 * (q4 & 1); const f32x2 pw = POW[(15 - j) * 64 + p]; float v[8];
#pragma unroll
              for (int jj = 0; jj < 8; ++jj) { const f32x2 bb = BB[p * 16 + c0 + jj]; v[jj] = ri ? (pw.x * bb.y + pw.y * bb.x) : (pw.x * bb.x - pw.y * bb.y); }
              v4u pk; pk.x = pk2(v[0], v[1]); pk.y = pk2(v[2], v[3]); pk.z = pk2(v[4], v[5]); pk.w = pk2(v[6], v[7]); afA[ks] = __builtin_bit_cast(bf16x8, pk); } }
#pragma unroll
        for (int ts = 0; ts < 2; ++ts) { const int i = ts ? 15 - w : w;
#pragma unroll
            for (int ks = 0; ks < 4; ++ks) { float v[8];
#pragma unroll
                for (int pp = 0; pp < 4; ++pp) { const int p = 16 * ks + 4 * q4 + pp; const f32x2 cc = CC[l15 * 64 + p], pw = POW[(i + 1) * 64 + p];
                    v[2 * pp] = cc.x * pw.x - cc.y * pw.y; v[2 * pp + 1] = -(cc.x * pw.y + cc.y * pw.x); }
                v4u pk; pk.x = pk2(v[0], v[1]); pk.y = pk2(v[2], v[3]); pk.z = pk2(v[4], v[5]); pk.w = pk2(v[6], v[7]); afC[ts][ks] = __builtin_bit_cast(bf16x8, pk); } }
        const f32x2 a16 = POW[16 * 64 + lane];
        float sr = 0.f, si = 0.f;
        for (int half = 0; half < 2; ++half) {
            __syncthreads();
            const size_t row0 = (size_t)b * SEQ + 1024 * half;
#pragma unroll
            for (int k = 0; k < 4; ++k) { const int idx = tid + 512 * k, tok = idx >> 1, hf = idx & 1;
                const v4u uv = *(const v4u*)(PROJ + (row0 + tok) * PLD + 4096 + 16 * g + 8 * hf);
                *(LAS v4u*)(UL + (tok >> 4) * 528 + ((tok & 15) * 16 + 8 * hf) * 2) = uv; }
            __syncthreads();
#pragma unroll
            for (int nt = 0; nt < 4; ++nt) { f32x4 acc = (f32x4){0.f, 0.f, 0.f, 0.f};
#pragma unroll
                for (int ks = 0; ks < 8; ++ks) { const bf16x8 bb = *(const LAS bf16x8*)(UL + (16 * nt + l15) * 528 + (32 * ks + 8 * q4) * 2); acc = mfma16(afA[ks], bb, acc); }
                *(LAS f32x4*)(EL + (16 * nt + l15) * 132 + 16 * w + 4 * q4) = acc; }
            __syncthreads();
            if (w == 0) {
#pragma unroll 8
                for (int c = 0; c < 64; ++c) { *(LAS unsigned*)(S0L + c * 272 + lane * 4) = pk2(sr, si);
                    const f32x2 e = *(const LAS f32x2*)(EL + c * 132 + 2 * lane);
                    const float nr = a16.x * sr - a16.y * si + e.x, ni = a16.x * si + a16.y * sr + e.y; sr = nr; si = ni; }
            }
            __syncthreads();
#pragma unroll
            for (int ts = 0; ts < 2; ++ts) { const int i = ts ? 15 - w : w; const int jl = q4 >> 1, c0 = 8 * (q4 & 1);
                bf16x8 kf[8];
#pragma unroll
                for (int ks = 0; ks < 8; ++ks) { const int j = 2 * ks + jl; v4u z = (v4u){0u, 0u, 0u, 0u};
                    if (j <= i) z = *(const LAS v4u*)(KTAB + ((i - j) * 16 + l15) * 16 + c0);
                    kf[ks] = __builtin_bit_cast(bf16x8, z); }
#pragma unroll
                for (int nt = 0; nt < 4; ++nt) { f32x4 acc = (f32x4){0.f, 0.f, 0.f, 0.f};
#pragma unroll
                    for (int ks = 0; ks < 8; ++ks) if (2 * ks <= i) { const bf16x8 bb = *(const LAS bf16x8*)(UL + (16 * nt + l15) * 528 + (32 * ks + 8 * q4) * 2); acc = mfma16(kf[ks], bb, acc); }
#pragma unroll
                    for (int ks = 0; ks < 4; ++ks) { const bf16x8 bb = *(const LAS bf16x8*)(S0L + (16 * nt + l15) * 272 + (32 * ks + 8 * q4) * 2); acc = mfma16(afC[ts][ks], bb, acc); }
                    v2u o; o.x = pk2(gelu_tanh_f(acc[0]), gelu_tanh_f(acc[1])); o.y = pk2(gelu_tanh_f(acc[2]), gelu_tanh_f(acc[3]));
                    *(v2u*)(YPRE + (row0 + 16 * (16 * nt + l15) + i) * 1024 + 16 * g + 4 * q4) = o; }
            }
        }
    }
}
#ifndef MK_PROBE
#define MK_PROBE 0
#endif
#ifndef PH_MASK
#define PH_MASK 0xffffffffu
#endif
#define EN(k) (((PH_MASK) >> (k)) & 1u)
#ifndef REP_MASK
#define REP_MASK 0u
#endif
#if MK_PROBE
#define RUN(k, ...) do { if (EN(k)) { const int nr_ = 1 + (int)((rep_mask >> (k)) & 1u); _Pragma("nounroll") for (int r_ = 0; r_ < nr_; ++r_) { __VA_ARGS__; if (r_ + 1 < nr_) xcd_barrier(bar); } } } while (0)
#else
#define RUN(k, ...) do { if (EN(k)) { __VA_ARGS__; } } while (0)
#endif
#define W_X ((float*)(ws + WS_X))
#define W_X2 ((float*)(ws + WS_X2))
#define W_H ((bf16*)(ws + WS_H))
#define W_PROJ ((bf16*)(ws + WS_PROJ))
#define W_MIX ((bf16*)(ws + WS_MIX))
#define W_Y ((float*)(ws + WS_Y))
#define W_HID ((bf16*)(ws + WS_HID))
#define W_MOD ((float*)(ws + WS_MOD))
#define W_YPRE ((bf16*)(ws + WS_YPRE))
#define W_ODN ((float*)(ws + WS_ODN))
#define W_CHU ((bf16*)(ws + WS_CHU))
#define W_CHW ((bf16*)(ws + WS_CHW))
#define W_CHQD ((bf16*)(ws + WS_CHQD))
#define W_CHKT ((bf16*)(ws + WS_CHKT))
#define W_CHA ((bf16*)(ws + WS_CHA))
#define W_CHGL ((float*)(ws + WS_CHGL))
#define W_S5END ((float*)(ws + WS_S5END))
__global__ void __launch_bounds__(512, 2) fwd(Args args) {
    extern __shared__ __attribute__((aligned(16))) unsigned char lds_raw[];
    LAS unsigned char* lds = (LAS unsigned char*)lds_raw;
    const int G = gridDim.x;
    const int lo = args.ph_lo, hi = args.ph_hi;
#if MK_PROBE
    const unsigned rep_mask = args.rep;
#endif
    volatile LAS unsigned* MISC = (volatile LAS unsigned*)(lds + LDS_MISC);
    if (threadIdx.x < 8) MISC[threadIdx.x] = 0u;
    __syncthreads();
    XcdBarrier bar; bar.bar = (unsigned*)(args.ws + WS_CTL) + CW_BAR; bar.x = 0; bar.st = nullptr;
    if (hi - lo > 1) bar = xcd_barrier_post((unsigned*)(args.ws + WS_CTL) + CW_BAR, MISC);
#define IN(k) (lo <= (k) && (k) < hi)
#define SEAM(k) do { if ((k) + 1 < hi) xcd_barrier(bar); } while (0)
#define PH_ARGS KArgs ap = kargs(); unsigned char* ws = ap->ws; (void)ws

    if (IN(0)) { PH_ARGS; RUN(0, p0a_phase(lds, ap, G)); SEAM(0); }
    if (IN(1)) { PH_ARGS; RUN(1, modulate_phase(ap->in[0], W_MOD, 0, 2048, W_H, G)); SEAM(1); }

#pragma nounroll
    for (int i = 0; i < 4; ++i) {
        const int j = i >> 1; const bool odd = (i & 1) != 0;
        int p = 2 + j * 16 + (odd ? 9 : 0);
        if (IN(p)) { PH_ARGS;
            pg8::Gemm g{W_H, (const bf16*)(ws + WS_WIN + i * WIN_STRIDE), MTOK, odd ? NIN_O : NIN_E, DM}; pg8::StaticOrder S; S.init(MTOK, g.N, G, (int)blockIdx.x);
            pg8::EpiB16 E{W_PROJ, PLD};
            RUN(2, pg8::gemm_phase<pg8::EpiB16, pg8::StaticOrder, true, true>(lds, g, S, E));
            SEAM(p);
        }
        ++p;
        if (!odd) {
            if (IN(p)) { PH_ARGS;
                RUN(3, dn_prep_phase(lds, W_PROJ, ap->in[13] + (size_t)j * 4 * 3072, ap->in[14] + j * 8, ap->in[15] + j * 8, W_CHU, W_CHW, W_CHQD, W_CHKT, W_CHA, W_CHGL, G));
                SEAM(p);
            }
            ++p;
            if (IN(p)) { PH_ARGS;
                const int first = (G >= 256) ? 128 : 0;
                RUN(5, if ((int)blockIdx.x < 128 || first == 0) dn_scan_phase(lds, W_CHU, W_CHW, W_CHQD, W_CHKT, W_CHA, W_CHGL, W_ODN, (first == 0) ? G : 128));
                RUN(6, if ((int)blockIdx.x >= first) s5_phase(lds, W_PROJ, ap->in[17] + (size_t)j * 4096, ap->in[18] + (size_t)j * 4096, ap->in[19] + (size_t)j * 65536, ap->in[20] + (size_t)j * 65536,
                                                              ap->in[21] + (size_t)j * 65536, ap->in[22] + (size_t)j * 65536, ap->in[23] + (size_t)j * 1024, ap->in[24] + (size_t)j * 64, W_YPRE, first, G - first));
                SEAM(p);
            }
            ++p;
            if (IN(p)) { PH_ARGS;
                pg8::Gemm g{W_YPRE, (const bf16*)(ws + WS_WGLU + j * WGLU_STRIDE), MTOK, 1024, 1024}; pg8::StaticOrder S; S.init(MTOK, 1024, G, (int)blockIdx.x);
                pg8::EpiGlu E{W_YPRE, 1024, W_MIX, DM, 1024};
                RUN(7, pg8::gemm_phase<pg8::EpiGlu, pg8::StaticOrder, true, true>(lds, g, S, E));
                RUN(8, dn_gate_phase(W_ODN, W_PROJ, ap->in[16] + j * 128, W_MIX, G));
                SEAM(p);
            }
            ++p;
        } else {
            if (IN(p)) { PH_ARGS;
                RUN(9, shortconv_phase(W_PROJ, ap->in[28] + (size_t)j * 3 * 1024, W_MIX, G));
                const float lambda_init = (i == 1) ? 0.35550906759277307f : 0.55605818415556050f;
                RUN(10, attn_phase(lds, W_PROJ, W_MIX, ap->in[29] + j * 128, ap->in[30] + j * 128, ap->in[31] + j * 128, ap->in[32] + j * 128, ap->in[33] + j * 256, lambda_init, G));
                SEAM(p);
            }
            ++p;
        }
        if (IN(p)) { PH_ARGS;
            pg8::Gemm g{W_MIX, (const bf16*)(ws + WS_WOUT + i * WOUT_STRIDE), MTOK, DM, DM}; pg8::StaticOrder S; S.init(MTOK, DM, G, (int)blockIdx.x);
            pg8::EpiF32o E{W_Y, DM};
            RUN(11, pg8::gemm_phase<pg8::EpiF32o, pg8::StaticOrder, true, true>(lds, g, S, E));
            SEAM(p);
        }
        ++p;
        if (IN(p)) { PH_ARGS; const float* MODl = W_MOD + (size_t)i * 4 * 12288;
            RUN(12, ln_phase((i == 0) ? ap->in[0] : W_X, W_Y, W_X2, W_H, MODl + 4096, ap->in[4] + i * DM, ap->in[5] + i * DM, MODl, 6144, 8192, G)); SEAM(p); }
        ++p;
        if (IN(p)) { PH_ARGS;
            pg8::Gemm g{W_H, (const bf16*)(ws + WS_WGU + i * WGU_STRIDE), MTOK, 2 * DFF, DM}; pg8::StaticOrder S; S.init(MTOK, 2 * DFF, G, (int)blockIdx.x);
            pg8::EpiSwiGlu E{W_HID, DFF};
            RUN(13, pg8::gemm_phase<pg8::EpiSwiGlu, pg8::StaticOrder, true, true>(lds, g, S, E));
            SEAM(p);
        }
        ++p;
        if (IN(p)) { PH_ARGS;
            pg8::Gemm g{W_HID, (const bf16*)(ws + WS_WDN + i * WDN_STRIDE), MTOK, DM, DFF}; pg8::StaticOrder S; S.init(MTOK, DM, G, (int)blockIdx.x);
            pg8::EpiF32o E{W_Y, DM};
            RUN(14, pg8::gemm_phase<pg8::EpiF32o, pg8::StaticOrder, true, true>(lds, g, S, E));
            SEAM(p);
        }
        ++p;
        if (IN(p)) { PH_ARGS; const float* MODl = W_MOD + (size_t)i * 4 * 12288;
            RUN(15, ln_phase(W_X2, W_Y, (i < 3) ? W_X : ap->out, W_H, MODl + 10240, ap->in[6] + i * DM, ap->in[7] + i * DM, (i < 3) ? MODl + 4 * 12288 : nullptr, 0, 2048, G));
            SEAM(p);
        }
        ++p;
    }
#undef IN
#undef SEAM
}

extern "C" void kernel_launch(void* const* d_in, const int* in_sizes, int n_in, void* d_out, int out_size, void* d_ws, size_t ws_size, hipStream_t stream) {
    static int grid = 0;
    if (grid == 0) {
        if (n_in != 34 || in_sizes[0] != MTOK * DM || out_size != MTOK * DM || ws_size < WS_END) {
            fprintf(stderr, "kernel_launch: unexpected shapes (n_in %d, in0 %d, out %d, ws %zu < %zu); nothing launched\n", n_in, n_in > 0 ? in_sizes[0] : -1, out_size, ws_size, (size_t)WS_END); grid = -1; return; }
        int dev = 0, cus = 0;
        if (hipGetDevice(&dev) != hipSuccess || hipDeviceGetAttribute(&cus, hipDeviceAttributeMultiprocessorCount, dev) != hipSuccess) { fprintf(stderr, "kernel_launch: device query failed\n"); grid = -1; return; }
        if (hipFuncSetAttribute((const void*)fwd, hipFuncAttributeMaxDynamicSharedMemorySize, LDS_BYTES) != hipSuccess) { fprintf(stderr, "kernel_launch: hipFuncSetAttribute failed\n"); grid = -1; return; }
        int per_cu = 0;
        if (hipOccupancyMaxActiveBlocksPerMultiprocessor(&per_cu, (const void*)fwd, 512, LDS_BYTES) != hipSuccess || per_cu < 1) fprintf(stderr, "kernel_launch: note: occupancy query reports %d\n", per_cu);
        (void)hipGetLastError();
        grid = cus;
    }
    if (grid < 0) return;
    if (hipMemsetAsync((char*)d_ws + WS_CTL, 0, CTL_ZERO_BYTES, stream) != hipSuccess) { fprintf(stderr, "kernel_launch: memset failed\n"); return; }
    Args a{};
    for (int i = 0; i < 34; ++i) a.in[i] = (const float*)d_in[i];
    a.out = (float*)d_out; a.ws = (unsigned char*)d_ws; a.rep = REP_MASK; a.pad = 0u;
#if MK_MULTI
    for (int p = 0; p < NPH; ++p) { a.ph_lo = p; a.ph_hi = p + 1; hipLaunchKernelGGL(fwd, dim3(grid), dim3(512), LDS_BYTES, stream, a); }
#else
    a.ph_lo = 0; a.ph_hi = NPH; hipLaunchKernelGGL(fwd, dim3(grid), dim3(512), LDS_BYTES, stream, a);
#endif
    const hipError_t le = hipPeekAtLastError();
    if (le != hipSuccess) fprintf(stderr, "kernel_launch: launch failed: %s\n", hipGetErrorName(le));
}
```
